# Optimizing an MI355X kernel written in HIP

```python
import math
import jax, jax.numpy as jnp
from jax import lax
import numpy as np

D_MODEL = 4096
BATCH = 4
SEQ = 4096
DEPTH = 1

CHUNK = 64
Q_BLOCK = 128
HEAD_DIM = 128
N_HEADS_DSA = D_MODEL // 2 // HEAD_DIM
N_HEADS_FOX = D_MODEL // 2 // HEAD_DIM
D_LATENT = 512
N_IDX_HEADS = 32
IDX_DIM = 128
TOPK_MAX = 256
D_FF = 11008
N_BUCKETS = 32
MAX_DISTANCE = 128
ALPHA = (2.0 * DEPTH) ** 0.25
BETA = (8.0 * DEPTH) ** -0.25
LN_EPS = 1e-5
RMS_EPS = 1e-6
NEG = -1e30

W_DSA = N_HEADS_DSA * HEAD_DIM
W_FOX = N_HEADS_FOX * HEAD_DIM
MIX_WIDTH = W_DSA + W_FOX
SPLITS = (W_DSA,
          D_LATENT,
          N_IDX_HEADS * IDX_DIM,
          IDX_DIM,
          N_IDX_HEADS,
          W_FOX, W_FOX, W_FOX,
          N_HEADS_FOX)
D_IN = W_DSA + D_LATENT + N_IDX_HEADS * IDX_DIM + IDX_DIM + N_IDX_HEADS + 3 * W_FOX + N_HEADS_FOX

kernel_name = "hybrid_dsa_fox_macaron_deepnorm"


def split_offsets():
    offs, acc = [], 0
    for w in SPLITS[:-1]:
        acc += w
        offs.append(acc)
    return offs


def layer_norm(x, g, b):
    xf = x.astype(jnp.float32)
    mu = jnp.mean(xf, axis=-1, keepdims=True)
    var = jnp.mean(jnp.square(xf - mu), axis=-1, keepdims=True)
    y = (xf - mu) * lax.rsqrt(var + LN_EPS) * g.astype(jnp.float32) + b.astype(jnp.float32)
    return y.astype(x.dtype)


def rms_norm(x, g):
    xf = x.astype(jnp.float32)
    y = xf * lax.rsqrt(jnp.mean(jnp.square(xf), axis=-1, keepdims=True) + RMS_EPS) * g.astype(jnp.float32)
    return y.astype(x.dtype)


def swiglu(x, w_gate, w_up, w_down):
    return (jax.nn.silu(x @ w_gate) * (x @ w_up)) @ w_down


def t5_bucket(rel):
    nb = N_BUCKETS // 2
    max_exact = nb // 2
    ret = jnp.where(rel > 0, nb, 0)
    n = jnp.abs(rel)
    nf = jnp.maximum(n, 1).astype(jnp.float32)
    large = max_exact + (jnp.log(nf / max_exact) / math.log(MAX_DISTANCE / max_exact)
                         * (nb - max_exact)).astype(jnp.int32)
    large = jnp.minimum(large, nb - 1)
    return ret + jnp.where(n < max_exact, n, large)


def to_blocks(a):
    b, s = a.shape[:2]
    return jnp.moveaxis(a.reshape((b, s // Q_BLOCK, Q_BLOCK) + a.shape[2:]), 1, 0)


def from_blocks(a):
    a = jnp.moveaxis(a, 0, 1)
    b, nblk, qb = a.shape[:3]
    return a.reshape(b, nblk * qb, -1)


def dsa_mixer(q, c_kv, q_idx, k_idx, w_idx, w_uk, w_uv, rel_bias):
    b, s = q.shape[:2]
    k_sel = min(TOPK_MAX, s // 4)
    key_chunk = jnp.arange(s) // CHUNK
    scale = HEAD_DIM ** -0.5
    idx_scale = IDX_DIM ** -0.5
    w_scale = N_IDX_HEADS ** -0.5

    def block(args):
        qb, qi, wi, start = args
        t = start + jnp.arange(Q_BLOCK)
        t_chunk = t // CHUNK
        s_h = jnp.einsum('bthd,bsd->bths', qi, k_idx).astype(jnp.float32) * idx_scale
        score = jnp.einsum('bth,bths->bts', wi.astype(jnp.float32) * w_scale, jax.nn.relu(s_h))
        admissible = key_chunk[None, :] <= t_chunk[:, None]
        score = jnp.where(admissible[None], score, -jnp.inf)
        _, idx = lax.top_k(score, k_sel)
        c_sel = jax.vmap(lambda c, i: c[i])(c_kv, idx)
        valid = (idx // CHUNK) <= t_chunk[None, :, None]
        bias = rel_bias[t5_bucket(idx - t[None, :, None])]
        q_lat = jnp.einsum('bthd,hdc->bthc', qb, w_uk)
        logits = (jnp.einsum('bthc,btkc->bthk', q_lat, c_sel).astype(jnp.float32) * scale
                  + jnp.moveaxis(bias, -1, 2).astype(jnp.float32))
        logits = jnp.where(valid[:, :, None, :], logits, NEG)
        p = jax.nn.softmax(logits, axis=-1).astype(c_sel.dtype)
        o_lat = jnp.einsum('bthk,btkc->bthc', p, c_sel)
        return jnp.einsum('bthc,hcd->bthd', o_lat, w_uv)

    starts = jnp.arange(s // Q_BLOCK) * Q_BLOCK
    out = lax.map(block, (to_blocks(q), to_blocks(q_idx), to_blocks(w_idx), starts))
    return from_blocks(out)


def fox_mixer(q, k, v, log_f):
    s = q.shape[1]
    scale = HEAD_DIM ** -0.5
    cum = jnp.cumsum(log_f, axis=1)
    cum_k = jnp.moveaxis(cum, -1, 1)
    key_pos = jnp.arange(s)

    def block(args):
        qb, cq, start = args
        t = start + jnp.arange(Q_BLOCK)
        logits = jnp.einsum('bthd,bshd->bhts', qb, k).astype(jnp.float32) * scale
        logits = logits + (jnp.moveaxis(cq, -1, 1)[..., None] - cum_k[:, :, None, :])
        mask = key_pos[None, :] <= t[:, None]
        logits = jnp.where(mask[None, None], logits, NEG)
        p = jax.nn.softmax(logits, axis=-1).astype(v.dtype)
        return jnp.einsum('bhts,bshd->bthd', p, v)

    starts = jnp.arange(s // Q_BLOCK) * Q_BLOCK
    out = lax.map(block, (to_blocks(q), to_blocks(cum), starts))
    return from_blocks(out)


def hybrid_mixer(h, w_in, b_f, kv_norm_g, idx_k_g, idx_k_b, w_uk, w_uv, rel_bias, w_out):
    b, s, _ = h.shape
    proj = h @ w_in
    q_a, c_kv, q_i, k_i, w_i, q_b, k_b, v_b, f_b = jnp.split(proj, split_offsets(), axis=-1)
    c_kv = rms_norm(c_kv, kv_norm_g)
    k_i = layer_norm(k_i, idx_k_g, idx_k_b)
    o_a = dsa_mixer(q_a.reshape(b, s, N_HEADS_DSA, HEAD_DIM), c_kv,
                    q_i.reshape(b, s, N_IDX_HEADS, IDX_DIM), k_i, w_i, w_uk, w_uv, rel_bias)
    log_f = jax.nn.log_sigmoid(f_b.astype(jnp.float32) + b_f.astype(jnp.float32))
    o_b = fox_mixer(q_b.reshape(b, s, N_HEADS_FOX, HEAD_DIM),
                    k_b.reshape(b, s, N_HEADS_FOX, HEAD_DIM),
                    v_b.reshape(b, s, N_HEADS_FOX, HEAD_DIM), log_f)
    return jnp.concatenate([o_a, o_b], axis=-1) @ w_out


def setup_inputs(seed: int = 0) -> dict:
    key = jax.random.key(seed)
    ks = jax.random.split(key, 24)
    f32 = jnp.float32

    def nrm(k, shape, scale):
        return jax.random.normal(k, shape, f32) * scale

    def gain(k, shape):
        return 1.0 + 0.02 * jax.random.normal(k, shape, f32)

    L = DEPTH
    b_f = (jnp.linspace(1.0, 6.0, N_HEADS_FOX, dtype=f32)[None, :]
           + 0.1 * jax.random.normal(ks[8], (L, N_HEADS_FOX), f32))
    return {
        "x": jax.random.normal(ks[0], (BATCH, SEQ, D_MODEL), f32),
        "ffn1_w_gate": nrm(ks[1], (L, D_MODEL, D_FF), D_MODEL ** -0.5),
        "ffn1_w_up": nrm(ks[2], (L, D_MODEL, D_FF), D_MODEL ** -0.5),
        "ffn1_w_down": nrm(ks[3], (L, D_FF, D_MODEL), BETA * D_FF ** -0.5),
        "ln1_g": gain(ks[4], (L, D_MODEL)),
        "ln1_b": nrm(ks[5], (L, D_MODEL), 0.02),
        "w_in": nrm(ks[6], (L, D_MODEL, D_IN), D_MODEL ** -0.5),
        "b_f": b_f,
        "kv_norm_g": gain(ks[9], (L, D_LATENT)),
        "idx_k_g": gain(ks[10], (L, IDX_DIM)),
        "idx_k_b": nrm(ks[11], (L, IDX_DIM), 0.02),
        "w_uk": nrm(ks[12], (L, N_HEADS_DSA, HEAD_DIM, D_LATENT), D_LATENT ** -0.5),
        "w_uv": nrm(ks[13], (L, N_HEADS_DSA, D_LATENT, HEAD_DIM), D_LATENT ** -0.5),
        "rel_bias": nrm(ks[14], (N_BUCKETS, N_HEADS_DSA), 0.5),
        "w_out": nrm(ks[15], (L, MIX_WIDTH, D_MODEL), BETA * MIX_WIDTH ** -0.5),
        "ln2_g": gain(ks[16], (L, D_MODEL)),
        "ln2_b": nrm(ks[17], (L, D_MODEL), 0.02),
        "ffn2_w_gate": nrm(ks[18], (L, D_MODEL, D_FF), D_MODEL ** -0.5),
        "ffn2_w_up": nrm(ks[19], (L, D_MODEL, D_FF), D_MODEL ** -0.5),
        "ffn2_w_down": nrm(ks[20], (L, D_FF, D_MODEL), BETA * D_FF ** -0.5),
        "ln3_g": gain(ks[21], (L, D_MODEL)),
        "ln3_b": nrm(ks[22], (L, D_MODEL), 0.02),
    }


def reference(x, ffn1_w_gate, ffn1_w_up, ffn1_w_down, ln1_g, ln1_b, w_in, b_f, kv_norm_g,
              idx_k_g, idx_k_b, w_uk, w_uv, rel_bias, w_out, ln2_g, ln2_b,
              ffn2_w_gate, ffn2_w_up, ffn2_w_down, ln3_g, ln3_b):
    h = x
    for l in range(DEPTH):
        h = layer_norm(ALPHA * h + 0.5 * swiglu(h, ffn1_w_gate[l], ffn1_w_up[l], ffn1_w_down[l]),
                       ln1_g[l], ln1_b[l])
        h = layer_norm(ALPHA * h + hybrid_mixer(h, w_in[l], b_f[l], kv_norm_g[l], idx_k_g[l],
                                                idx_k_b[l], w_uk[l], w_uv[l], rel_bias, w_out[l]),
                       ln2_g[l], ln2_b[l])
        h = layer_norm(ALPHA * h + 0.5 * swiglu(h, ffn2_w_gate[l], ffn2_w_up[l], ffn2_w_down[l]),
                       ln3_g[l], ln3_b[l])
    return h
```

```cpp
#include <hip/hip_runtime.h>
#include <cstdio>
#include <cstdint>

#ifndef MK_SINGLE
#define MK_SINGLE 1
#endif

#define GAS __attribute__((address_space(1)))
#define LAS __attribute__((address_space(3)))
typedef unsigned short bf16_t;
typedef short bf16x8 __attribute__((ext_vector_type(8)));
typedef short s16x4 __attribute__((ext_vector_type(4)));
typedef float f32x4 __attribute__((ext_vector_type(4)));
typedef float f32x2 __attribute__((ext_vector_type(2)));
typedef float f32x16 __attribute__((ext_vector_type(16)));
typedef unsigned u32x4 __attribute__((ext_vector_type(4)));
typedef unsigned u32x2 __attribute__((ext_vector_type(2)));
typedef int i32x4 __attribute__((ext_vector_type(4)));

constexpr int NB = 4, SEQ = 4096, M = NB * SEQ, DM = 4096, DFF = 11008;
constexpr int NH = 16, HD = 128, DLAT = 512, NIH = 32, IDIM = 128, TOPK = 256, CHUNK = 64;
constexpr int DIN = 12976, DINP = 13056, PROJW = 12800;
constexpr int PC_QA = 0, PC_QI = 2560, PC_QB = 6656, PC_KB = 8704, PC_VB = 10752;
constexpr int SM_KI = 0, SM_WI = 128, SM_FB = 160;
constexpr float ALPHA = 1.189207115002721f;
constexpr float LN_EPS = 1e-5f, RMS_EPS = 1e-6f;

constexpr size_t MiB = 1u << 20;
constexpr size_t WS_CTL = 0, CTL_ZERO_BYTES = 1 * MiB;
constexpr size_t WS_W1 = 1 * MiB;
constexpr size_t WS_WD = WS_W1 + 172 * MiB;
constexpr size_t WS_SCORES = WS_W1;
constexpr size_t WS_WIN = WS_WD + 86 * MiB;
constexpr size_t WS_WOUT = WS_WIN + 102 * MiB;
constexpr size_t WS_WUK = WS_WOUT + 32 * MiB;
constexpr size_t WS_WUV = WS_WUK + 4 * MiB;
constexpr size_t WS_XB = WS_WUV + 3 * MiB;
constexpr size_t WS_HID = WS_XB + 128 * MiB;
constexpr size_t WS_PROJ = WS_XB;
constexpr size_t WS_PRE = WS_HID + 344 * MiB;
constexpr size_t WS_QLAT = WS_PRE;
constexpr size_t WS_OLAT = WS_W1;
constexpr size_t WS_H1B = WS_PRE + 256 * MiB;
constexpr size_t WS_ATT = WS_H1B + 128 * MiB;
constexpr size_t WS_SMALL = WS_ATT + 128 * MiB;
constexpr size_t WS_CKVRAW = WS_SMALL + 16 * MiB;
constexpr size_t WS_CKV = WS_CKVRAW + 32 * MiB;
constexpr size_t WS_KI = WS_CKV + 16 * MiB;
constexpr size_t WS_IDX = WS_KI + 4 * MiB;
constexpr size_t WS_CUMK = WS_IDX + 16 * MiB;
constexpr size_t WS_END = WS_CUMK + 1 * MiB;
static_assert(WS_END <= (size_t)1562 * MiB, "workspace map exceeds the guaranteed size");
static_assert((size_t)22016 * 4096 * 2 <= 172 * MiB && (size_t)4096 * 11008 * 2 <= 86 * MiB && (size_t)DINP * 4096 * 2 <= 102 * MiB, "weights");
static_assert((size_t)M * PROJW * 2 <= 472 * MiB && (size_t)M * 4096 * 4 <= 258 * MiB, "overlays");

constexpr int CW_BAR = 4096;

constexpr int RING_BYTES = 131072;
constexpr int LDSCTL_OFF = 143360, MISC_OFF = LDSCTL_OFF + 320;
constexpr int LDS_BYTES = 147456;
constexpr int NWAVES = 8;

#define LDS_WAIT() asm volatile("s_waitcnt lgkmcnt(0)" ::: "memory")
#define VM_WAIT() asm volatile("s_waitcnt vmcnt(0)" ::: "memory")

__device__ __forceinline__ unsigned cvt_pk_bf16(float lo, float hi) { unsigned r; asm volatile("v_cvt_pk_bf16_f32 %0, %1, %2" : "=v"(r) : "v"(lo), "v"(hi)); return r; }
__device__ __forceinline__ float bf2f(unsigned short b) { return __builtin_bit_cast(float, (unsigned)b << 16); }
__device__ __forceinline__ float bflo(unsigned w) { return __builtin_bit_cast(float, w << 16); }
__device__ __forceinline__ float bfhi(unsigned w) { return __builtin_bit_cast(float, w & 0xffff0000u); }

#define XB_TMO      128
#define XB_XCNT(j)  (256  + 64 * (j))
#define XB_XSUB(j)  (1280 + 64 * (j))
#define XB_XGEN(j)  (2304 + 64 * (j))
#define XB_TOP      3328
#define XB_TOPGEN   3392
#define XCD_BAR_WORDS 3456
#define XB_SPIN_CAP (1u << 23)
__device__ __forceinline__ unsigned xb_ld(unsigned* p)              { return __hip_atomic_load(p, __ATOMIC_RELAXED, __HIP_MEMORY_SCOPE_AGENT); }
__device__ __forceinline__ unsigned xb_add(unsigned* p, unsigned v) { return __hip_atomic_fetch_add(p, v, __ATOMIC_RELAXED, __HIP_MEMORY_SCOPE_AGENT); }
__device__ __forceinline__ unsigned xb_xcc_id() { return (unsigned)__builtin_amdgcn_s_getreg((3 << 11) | 20) & 0xFu; }
#define XB_SPIN(cond, bar) do { unsigned _sp = 0; while (cond) { __builtin_amdgcn_s_sleep(1); \
    if ((++_sp & 255u) == 0u) { if (xb_ld(&(bar)[XB_TMO])) break; if (_sp > XB_SPIN_CAP) { atomicAdd(&(bar)[XB_TMO], 1u); break; } } } } while (0)
struct XcdBarrier { unsigned* bar; unsigned x; volatile LAS unsigned* st; };
__device__ __forceinline__ XcdBarrier xcd_barrier_post(unsigned* bar, volatile LAS unsigned* st, bool t0) {
    XcdBarrier b; b.bar = bar; b.x = xb_xcc_id(); b.st = st;
    if (t0) (void)xb_add(&bar[XB_XCNT(b.x)], 1u);
    return b;
}
__device__ __forceinline__ void xcd_barrier_complete(unsigned* bar, unsigned x, unsigned& nloc, unsigned& nx) {
    const unsigned G = gridDim.x * gridDim.y * gridDim.z;
    unsigned sum, cnt, mine, sp = 0u;
    for (;;) {
        sum = 0u; cnt = 0u; mine = 0u;
#pragma unroll
        for (unsigned j = 0; j < 16; ++j) { const unsigned c = xb_ld(&bar[XB_XCNT(j)]); sum += c; cnt += (c > 0u) ? 1u : 0u; mine = (j == x) ? c : mine; }
        if (sum == G) break;
        __builtin_amdgcn_s_sleep(1);
        if ((++sp & 255u) == 0u) { if (xb_ld(&bar[XB_TMO])) break; if (sp > XB_SPIN_CAP) { atomicAdd(&bar[XB_TMO], 1u); break; } }
    }
    nloc = mine > 0u ? mine : 1u; nx = cnt > 0u ? cnt : 1u;
}
__device__ __forceinline__ void xcd_barrier(const XcdBarrier& b, bool t0) {
    asm volatile("s_waitcnt vmcnt(0)" ::: "memory");
    __syncthreads();
    if (t0) {
        unsigned* bar = b.bar;
        __builtin_amdgcn_s_waitcnt(0);
        unsigned nloc = b.st[0], nx = b.st[1];
        if (nloc == 0u) { xcd_barrier_complete(bar, b.x, nloc, nx); b.st[0] = nloc; b.st[1] = nx; }
        const unsigned old = xb_add(&bar[XB_XSUB(b.x)], 1u);
        const unsigned gen = old / nloc;
        if (old + 1u == (gen + 1u) * nloc) {
            __builtin_amdgcn_fence(__ATOMIC_RELEASE, "agent");
            asm volatile("s_waitcnt vmcnt(0)" ::: "memory");
            const unsigned og = xb_add(&bar[XB_TOP], 1u);
            const unsigned tg = og / nx;
            if (og + 1u == (tg + 1u) * nx) xb_add(&bar[XB_TOPGEN], 1u);
            else XB_SPIN(xb_ld(&bar[XB_TOPGEN]) == tg, bar);
            __builtin_amdgcn_fence(__ATOMIC_ACQUIRE, "agent");
            xb_add(&bar[XB_XGEN(b.x)], 1u);
            asm volatile("s_waitcnt vmcnt(0)" ::: "memory");
        } else {
            XB_SPIN(xb_ld(&bar[XB_XGEN(b.x)]) == gen, bar);
            __builtin_amdgcn_fence(__ATOMIC_ACQUIRE, "agent");
            asm volatile("s_waitcnt vmcnt(0)" ::: "memory");
        }
    }
    __syncthreads();
}

namespace pg8 {
constexpr int BM = 256, BK = 64, HALF = 128, HTB = HALF * BK * 2, NXCD = 8, WGM = 8;
__host__ __device__ __forceinline__ int lds_byte(int r, int c) { const int st = (r >> 4) * 2 + (c >> 5), rr = r & 15, cc = c & 31, ob = rr * 64 + cc * 2; return st * 1024 + (ob ^ (((ob >> 9) & 1) << 5)); }
__host__ __device__ __forceinline__ void stage_rc(int b, int& R, int& C) { const int st = b / 1024, sb = b % 1024, swz = sb ^ (((sb >> 9) & 1) << 5); R = (st >> 1) * 16 + swz / 64; C = (st & 1) * 32 + (swz % 64) / 2; }
__host__ __device__ __forceinline__ int perm32(int rho) { const int n = rho >> 4, i = rho & 15; return 8 * (i >> 2) + 4 * n + (i & 3); }

struct Unit { int pm, pn, aoff, boff; };
struct Gemm { const bf16_t* A; const bf16_t* Bt; int lda, ldb, K; };

struct StaticOrder {
    int nM, nN, nwg, G, c, wgm;
    __host__ __device__ void init(int M_, int N_, int G_, int c_, int wgm_ = WGM) { nM = M_ / BM; nN = N_ / BM; nwg = nM * nN; G = G_; c = c_; wgm = wgm_; }
    __host__ __device__ bool next(int i, Unit& u) const {
        const long L = (long)i * G + c; if (L >= nwg) return false;
        int wgid = (int)L; { const int q = nwg / NXCD, r = nwg % NXCD, xcd = wgid % NXCD, off = wgid / NXCD; wgid = (xcd < r ? xcd * (q + 1) : r * (q + 1) + (xcd - r) * q) + off; }
        const int nig = wgm * nN, gid = wgid / nig, fm = gid * wgm, gsz = (nM - fm) < wgm ? (nM - fm) : wgm;
        u.pm = fm + ((wgid % nig) % gsz); u.pn = (wgid % nig) / gsz; u.aoff = 0; u.boff = 0; return true;
    }
};
struct QlatOrder : StaticOrder {
    __host__ __device__ bool next(int i, Unit& u) const { if (!StaticOrder::next(i, u)) return false; u.aoff = (u.pn >> 1) * 128; return true; }
};
struct OaOrder : StaticOrder {
    __host__ __device__ bool next(int i, Unit& u) const { if (!StaticOrder::next(i, u)) return false; u.aoff = u.pn * 512; u.boff = -(u.pn * 128) * 512; return true; }
};

__device__ __forceinline__ float silu_f(float x) { return x * __builtin_amdgcn_rcpf(1.0f + __builtin_amdgcn_exp2f(-1.4426950408889634f * x)); }

struct EpiSwiglu {
    static constexpr bool PERM = true;
    bf16_t* O; int ldc;
    __device__ __forceinline__ void operator()(const f32x4 (&acc)[2][2][4][2], const Unit& u, int wr, int wc, int fr, int fq) const {
        const int row0 = u.pm * BM + wr * 64 + fr, col0 = u.pn * HALF + wc * 32 + 8 * fq;
#pragma unroll
        for (int ai = 0; ai < 2; ++ai)
#pragma unroll
            for (int m = 0; m < 4; ++m) {
                const f32x4 g0 = acc[ai][0][m][0], g1 = acc[ai][0][m][1], u0 = acc[ai][1][m][0], u1 = acc[ai][1][m][1];
                u32x4 w;
                w.x = cvt_pk_bf16(silu_f(g0[0]) * u0[0], silu_f(g0[1]) * u0[1]); w.y = cvt_pk_bf16(silu_f(g0[2]) * u0[2], silu_f(g0[3]) * u0[3]);
                w.z = cvt_pk_bf16(silu_f(g1[0]) * u1[0], silu_f(g1[1]) * u1[1]); w.w = cvt_pk_bf16(silu_f(g1[2]) * u1[2], silu_f(g1[3]) * u1[3]);
                *(u32x4*)(O + (size_t)(row0 + ai * HALF + m * 16) * ldc + col0) = w;
            }
    }
};
template <bool RES_BF16> struct EpiResBf16 {
    static constexpr bool PERM = true;
    bf16_t* C; int ldc; const void* res; int ldr; float ra, rb;
    __device__ __forceinline__ void operator()(const f32x4 (&acc)[2][2][4][2], const Unit& u, int wr, int wc, int fr, int fq) const {
        const int row0 = u.pm * BM + wr * 64 + fr, col0 = u.pn * BM + wc * 32 + 8 * fq;
#pragma unroll
        for (int ai = 0; ai < 2; ++ai)
#pragma unroll
            for (int m = 0; m < 4; ++m) {
                const size_t r = (size_t)(row0 + ai * HALF + m * 16);
#pragma unroll
                for (int bj = 0; bj < 2; ++bj) {
                    const int c = col0 + bj * HALF;
                    f32x4 r0, r1;
                    if constexpr (RES_BF16) { const u32x4 w = *(const u32x4*)((const bf16_t*)res + r * ldr + c); r0 = (f32x4){bflo(w.x), bfhi(w.x), bflo(w.y), bfhi(w.y)}; r1 = (f32x4){bflo(w.z), bfhi(w.z), bflo(w.w), bfhi(w.w)}; }
                    else { r0 = *(const f32x4*)((const float*)res + r * ldr + c); r1 = *(const f32x4*)((const float*)res + r * ldr + c + 4); }
                    const f32x4 v0 = r0 * ra + acc[ai][bj][m][0] * rb, v1 = r1 * ra + acc[ai][bj][m][1] * rb;
                    u32x4 o; o.x = cvt_pk_bf16(v0[0], v0[1]); o.y = cvt_pk_bf16(v0[2], v0[3]); o.z = cvt_pk_bf16(v1[0], v1[1]); o.w = cvt_pk_bf16(v1[2], v1[3]);
                    *(u32x4*)(C + r * ldc + c) = o;
                }
            }
    }
};
struct EpiProj {
    static constexpr bool PERM = true;
    bf16_t* P; float* ckvraw; float* small_;
    __device__ __forceinline__ void operator()(const f32x4 (&acc)[2][2][4][2], const Unit& u, int wr, int wc, int fr, int fq) const {
        const int row0 = u.pm * BM + wr * 64 + fr, cl = wc * 32 + 8 * fq;
        float* fdst = nullptr; int fld = 0;
        if (u.pn == 8 || u.pn == 9) { fdst = ckvraw + (u.pn - 8) * 256; fld = DLAT; }
        else if (u.pn == 50) { fdst = small_; fld = 256; }
#pragma unroll
        for (int ai = 0; ai < 2; ++ai)
#pragma unroll
            for (int m = 0; m < 4; ++m) {
                const size_t r = (size_t)(row0 + ai * HALF + m * 16);
#pragma unroll
                for (int bj = 0; bj < 2; ++bj) {
                    const f32x4 v0 = acc[ai][bj][m][0], v1 = acc[ai][bj][m][1];
                    if (fdst) { float* p = fdst + r * fld + cl + bj * HALF; *(f32x4*)p = v0; *(f32x4*)(p + 4) = v1; }
                    else { u32x4 w; w.x = cvt_pk_bf16(v0[0], v0[1]); w.y = cvt_pk_bf16(v0[2], v0[3]); w.z = cvt_pk_bf16(v1[0], v1[1]); w.w = cvt_pk_bf16(v1[2], v1[3]);
                           *(u32x4*)(P + r * PROJW + u.pn * BM + cl + bj * HALF) = w; }
                }
            }
    }
};
template <bool HALF_ONLY> struct EpiBf16 {
    static constexpr bool PERM = true;
    bf16_t* O; int ldc;
    __device__ __forceinline__ void operator()(const f32x4 (&acc)[2][2][4][2], const Unit& u, int wr, int wc, int fr, int fq) const {
        const int row0 = u.pm * BM + wr * 64 + fr, col0 = u.pn * (HALF_ONLY ? HALF : BM) + wc * 32 + 8 * fq;
#pragma unroll
        for (int ai = 0; ai < 2; ++ai)
#pragma unroll
            for (int m = 0; m < 4; ++m) {
                bf16_t* rowp = O + (size_t)(row0 + ai * HALF + m * 16) * ldc + col0;
#pragma unroll
                for (int bj = 0; bj < (HALF_ONLY ? 1 : 2); ++bj) {
                    const f32x4 v0 = acc[ai][bj][m][0], v1 = acc[ai][bj][m][1];
                    u32x4 w; w.x = cvt_pk_bf16(v0[0], v0[1]); w.y = cvt_pk_bf16(v0[2], v0[3]); w.z = cvt_pk_bf16(v1[0], v1[1]); w.w = cvt_pk_bf16(v1[2], v1[3]);
                    *(u32x4*)(rowp + bj * HALF) = w;
                }
            }
    }
};

template <class Epi, class Sched, bool ALIGN_EPI>
__device__ __forceinline__ void gemm_phase(LAS unsigned char* lds, int wid, const Gemm g, const Sched& S, const Epi& E) {
    int lane_; asm volatile("v_mbcnt_lo_u32_b32 %0, -1, 0\n\tv_mbcnt_hi_u32_b32 %0, -1, %0" : "=v"(lane_));
    const int lane = lane_ & 63, tid = wid * 64 + lane, wr = wid >> 2, wc = wid & 3, fr = lane & 15, fq = lane >> 4;
    const int K = g.K, nt = K / BK;
    unsigned voffA[2], voffB[2];
#pragma unroll
    for (int i = 0; i < 2; ++i) { int R, C; stage_rc(tid * 16 + i * 8192, R, C); const int Rb = Epi::PERM ? ((R & ~31) + perm32(R & 31)) : R;
        voffA[i] = (unsigned)(R * g.lda + C) * 2u; voffB[i] = (unsigned)(Rb * g.ldb + C) * 2u; }
    const size_t kstep = (size_t)(BK * 2);
    const size_t hstepA = (size_t)HALF * g.lda * 2, hstepB = (size_t)HALF * g.ldb * 2;
    const unsigned ldsw = (unsigned)wid * 1024u;
    const int aoff = lds_byte(wr * 64 + fr, fq * 8), boff = lds_byte(wc * 32 + fr, fq * 8);
#define PG8_SA(b, h) (((b) * 2 + (h)) * HTB)
#define PG8_SB(b, h) ((4 + (b) * 2 + (h)) * HTB)
#define PG8_STAGE(bufoff, gbase, voff) do { _Pragma("unroll") for (int _i = 0; _i < 2; ++_i) \
        __builtin_amdgcn_global_load_lds((const unsigned*)((const char*)(gbase) + (voff)[_i]), (LAS unsigned*)(lds + (bufoff) + ldsw + _i * 8192), 16, 0, 0); } while (0)
#define PG8_LDA(dst, b, h) do { _Pragma("unroll") for (int m = 0; m < 4; ++m) _Pragma("unroll") for (int k = 0; k < 2; ++k) dst[m][k] = *(const LAS bf16x8*)(lds + PG8_SA(b, h) + aoff + m * 2048 + k * 1024); } while (0)
#define PG8_LDB(dst, b, h) do { _Pragma("unroll") for (int n = 0; n < 2; ++n) _Pragma("unroll") for (int k = 0; k < 2; ++k) dst[n][k] = *(const LAS bf16x8*)(lds + PG8_SB(b, h) + boff + n * 2048 + k * 1024); } while (0)
#define PG8_MMA(ai, bj, At, Bt) do { __builtin_amdgcn_s_setprio(1); _Pragma("unroll") for (int m = 0; m < 4; ++m) _Pragma("unroll") for (int n = 0; n < 2; ++n) _Pragma("unroll") for (int k = 0; k < 2; ++k) \
        acc[ai][bj][m][n] = __builtin_amdgcn_mfma_f32_16x16x32_bf16(Bt[n][k], At[m][k], acc[ai][bj][m][n], 0, 0, 0); __builtin_amdgcn_s_setprio(0); } while (0)
#define PG8_WAIT_V(n) asm volatile("s_waitcnt vmcnt(" #n ")" ::: "memory")
#define PG8_WAIT_L(n) asm volatile("s_waitcnt lgkmcnt(" #n ")" ::: "memory")
#define PG8_BAR __builtin_amdgcn_s_barrier()
#define PG8_SCHED __builtin_amdgcn_sched_barrier(0)
    Unit cur, nxt; int ui = 0;
    if (!S.next(0, cur)) return;
    f32x4 acc[2][2][4][2];
#pragma unroll
    for (int a = 0; a < 2; ++a)
#pragma unroll
        for (int b = 0; b < 2; ++b)
#pragma unroll
            for (int m = 0; m < 4; ++m)
#pragma unroll
                for (int n = 0; n < 2; ++n) acc[a][b][m][n] = (f32x4){0.f, 0.f, 0.f, 0.f};
    bf16x8 At[4][2], B0[2][2], B1[2][2];
    const char* cA = (const char*)g.A + ((size_t)cur.pm * BM * g.lda + cur.aoff) * 2; const char* cB = (const char*)g.Bt + ((long)cur.pn * BM * g.ldb + cur.boff) * 2;
    PG8_STAGE(PG8_SB(0, 0), cB, voffB); PG8_STAGE(PG8_SB(0, 1), cB + hstepB, voffB); PG8_STAGE(PG8_SA(0, 0), cA, voffA); PG8_STAGE(PG8_SA(0, 1), cA + hstepA, voffA);
    if (wr == 1) PG8_BAR;
    PG8_WAIT_V(2); PG8_BAR;
    PG8_STAGE(PG8_SB(1, 0), cB + kstep, voffB); PG8_STAGE(PG8_SA(1, 0), cA + kstep, voffA); PG8_STAGE(PG8_SB(1, 1), cB + hstepB + kstep, voffB);
    PG8_WAIT_V(6); PG8_BAR;
    for (;;) {
        const bool has_next = S.next(ui + 1, nxt);
        const char* nA = has_next ? (const char*)g.A + ((size_t)nxt.pm * BM * g.lda + nxt.aoff) * 2 : cA; const char* nB = has_next ? (const char*)g.Bt + ((long)nxt.pn * BM * g.ldb + nxt.boff) * 2 : cB;
        for (int t = 0; t < nt; t += 2) {
            const bool last = (t == nt - 2);
            const char* a1 = cA + (size_t)(t + 1) * kstep;
            const char* a2 = last ? nA : cA + (size_t)(t + 2) * kstep; const char* b2 = last ? nB : cB + (size_t)(t + 2) * kstep;
            const char* a3 = a2 + kstep; const char* b3 = b2 + kstep;
            PG8_LDB(B0, 0, 0); PG8_LDB(B1, 0, 1); PG8_SCHED; PG8_LDA(At, 0, 0); PG8_STAGE(PG8_SA(1, 1), a1 + hstepA, voffA);
            PG8_WAIT_V(8); PG8_WAIT_L(0); PG8_BAR; PG8_MMA(0, 0, At, B0); PG8_MMA(0, 1, At, B1); PG8_BAR; PG8_SCHED;
            PG8_LDA(At, 0, 1); PG8_STAGE(PG8_SB(0, 0), b2, voffB); PG8_STAGE(PG8_SB(0, 1), b2 + hstepB, voffB); PG8_STAGE(PG8_SA(0, 0), a2, voffA);
            PG8_WAIT_V(8); PG8_WAIT_L(0); PG8_BAR; PG8_MMA(1, 0, At, B0); PG8_MMA(1, 1, At, B1); PG8_BAR; PG8_SCHED;
            PG8_LDB(B0, 1, 0); PG8_LDB(B1, 1, 1); PG8_SCHED; PG8_LDA(At, 1, 0); PG8_STAGE(PG8_SA(0, 1), a2 + hstepA, voffA);
            PG8_WAIT_V(8); PG8_WAIT_L(0); PG8_BAR; PG8_MMA(0, 0, At, B0); PG8_MMA(0, 1, At, B1); PG8_BAR; PG8_SCHED;
            PG8_LDA(At, 1, 1); PG8_STAGE(PG8_SB(1, 0), b3, voffB); PG8_STAGE(PG8_SB(1, 1), b3 + hstepB, voffB); PG8_STAGE(PG8_SA(1, 0), a3, voffA);
            PG8_WAIT_V(8); PG8_WAIT_L(0); PG8_BAR; PG8_MMA(1, 0, At, B0); PG8_MMA(1, 1, At, B1); PG8_BAR; PG8_SCHED;
        }
        if constexpr (ALIGN_EPI) { if (wr == 0) PG8_BAR; }
        E(acc, cur, wr, wc, fr, fq);
        if (!has_next) break;
#pragma unroll
        for (int a = 0; a < 2; ++a)
#pragma unroll
            for (int b = 0; b < 2; ++b)
#pragma unroll
                for (int m = 0; m < 4; ++m)
#pragma unroll
                    for (int n = 0; n < 2; ++n) acc[a][b][m][n] = (f32x4){0.f, 0.f, 0.f, 0.f};
        cur = nxt; cA = nA; cB = nB; ++ui;
        if constexpr (ALIGN_EPI) { if (wr == 1) PG8_BAR; }
    }
    PG8_WAIT_V(0);
    if constexpr (!ALIGN_EPI) { if (wr == 0) PG8_BAR; }
    PG8_BAR;
#undef PG8_SA
#undef PG8_SB
#undef PG8_STAGE
#undef PG8_LDA
#undef PG8_LDB
#undef PG8_MMA
#undef PG8_WAIT_V
#undef PG8_WAIT_L
#undef PG8_BAR
#undef PG8_SCHED
}
}

namespace fox {
constexpr int NW = 8, QBLK = 32, KVBLK = 64, QB = NW * QBLK, D = 128;
constexpr int SHM_V = KVBLK * D * 2, SHM_K = KVBLK * D * 2;
constexpr int OFF_WS = 2 * SHM_V + 2 * SHM_K, OFF_BL = OFF_WS + NW * 64 * 4, LDS_BYTES = OFF_BL + 512;
constexpr float SCALE = 0.08838834764831845f, THR = 8.f;
constexpr int LDQ = PROJW, LDO = DM;
constexpr unsigned WINF = 0x7fffffffu;

#define KSWZ(row, colB) ((row) * 256 + ((colB) ^ (((row) & 7) << 4)))
#define SBAR() __builtin_amdgcn_sched_barrier(0)
__device__ __forceinline__ int v_st(int k, int c) { const int kk = (k & ~0xC) | ((k & 4) << 1) | ((k & 8) >> 1); return ((kk >> 3) * 4 + (c >> 5)) * 512 + ((kk & 7) * 32 + (c & 31)) * 2; }
__device__ __forceinline__ int v_rd_base(int lane) { return ((lane & 3) << 3) | (((lane >> 2) & 3) << 6) | (((lane >> 4) & 1) << 5) | (((lane >> 5) & 1) << 8); }
constexpr int v_rd_off(int d0, int ks, int half) { return d0 * 512 + ks * 4096 + half * 2048; }
__device__ __forceinline__ int crow(int r, int hi) { return (r & 3) + 8 * (r >> 2) + 4 * hi; }
__device__ __forceinline__ unsigned cvtpk(float lo, float hi) { unsigned r; asm volatile("v_cvt_pk_bf16_f32 %0, %1, %2" : "=v"(r) : "v"(lo), "v"(hi)); return r; }
__device__ __forceinline__ bf16x8 load8(const bf16_t* p) { return *reinterpret_cast<const bf16x8*>(p); }
__device__ __forceinline__ void mask_tile(f32x16& p0, f32x16& p1, int dq) {
    const float NEG = -__builtin_inff();
#pragma unroll
    for (int r = 0; r < 16; ++r) {
        const int c = (r & 3) + 8 * (r >> 2);
        if (dq - c < 0) p0[r] = NEG;
        if (dq - c - 32 < 0) p1[r] = NEG;
    }
}
__device__ __forceinline__ void partialSM(f32x16& p0, f32x16& p1, float& m_reg, float& mn, float& alpha) {
    float pmax = p0[0]; for (int r = 1; r < 16; ++r) pmax = fmaxf(pmax, p0[r]); for (int r = 0; r < 16; ++r) pmax = fmaxf(pmax, p1[r]);
    { auto rr = __builtin_amdgcn_permlane32_swap(__float_as_uint(pmax), __float_as_uint(pmax), false, false);
      pmax = fmaxf(__uint_as_float(rr[0]), __uint_as_float(rr[1])); }
    constexpr float C2 = 1.4426950408889634f * SCALE;
    if (__builtin_expect(__all((pmax - m_reg) * SCALE <= THR), 1)) { mn = m_reg; alpha = 1.f; }
    else { mn = fmaxf(m_reg, pmax); alpha = __builtin_amdgcn_exp2f((m_reg - mn) * C2); m_reg = mn; }
    const float mnL = -mn * C2;
    for (int r = 0; r < 16; ++r) p0[r] = fmaf(p0[r], C2, mnL); for (int r = 0; r < 16; ++r) p1[r] = fmaf(p1[r], C2, mnL);
    for (int r = 0; r < 16; ++r) p0[r] = __builtin_amdgcn_exp2f(p0[r]);
}
__device__ __forceinline__ void finishSM(f32x16& p0, f32x16& p1, float alpha, float& l_reg, bf16x8& pa0, bf16x8& pa1, bf16x8& pa2, bf16x8& pa3) {
    for (int r = 0; r < 16; ++r) p1[r] = __builtin_amdgcn_exp2f(p1[r]);
    float ps = 0; for (int r = 0; r < 16; ++r) ps += p0[r]; for (int r = 0; r < 16; ++r) ps += p1[r];
    { auto rr = __builtin_amdgcn_permlane32_swap(__float_as_uint(ps), __float_as_uint(ps), false, false);
      ps = __uint_as_float(rr[0]) + __uint_as_float(rr[1]); }
    l_reg = l_reg * alpha + ps;
#define PK4(P, B_, OUT) do { unsigned a0 = cvtpk(P[B_+0], P[B_+1]), a1 = cvtpk(P[B_+2], P[B_+3]);                          \
        unsigned b0 = cvtpk(P[B_+4], P[B_+5]), b1 = cvtpk(P[B_+6], P[B_+7]);                                             \
        auto r0 = __builtin_amdgcn_permlane32_swap(a0, b0, false, false); auto r1 = __builtin_amdgcn_permlane32_swap(a1, b1, false, false); \
        u32x4 w = {r0[0], r1[0], r0[1], r1[1]}; OUT = *reinterpret_cast<bf16x8*>(&w); } while (0)
    PK4(p0, 0, pa0); PK4(p0, 8, pa1); PK4(p1, 0, pa2); PK4(p1, 8, pa3);
#undef PK4
}
template <int KB>
__device__ __forceinline__ void qkt(f32x16& p0, f32x16& p1, const char* K_lds, const char* BL, int r32, int hi, const bf16x8* qr) {
    { const f32x4* bp = reinterpret_cast<const f32x4*>(BL + KB * 256 + hi * 16);
      const f32x4 a0 = bp[0], a1 = bp[2], a2 = bp[4], a3 = bp[6], c0 = bp[8], c1 = bp[10], c2 = bp[12], c3 = bp[14];
      p0 = (f32x16){a0[0], a0[1], a0[2], a0[3], a1[0], a1[1], a1[2], a1[3], a2[0], a2[1], a2[2], a2[3], a3[0], a3[1], a3[2], a3[3]};
      p1 = (f32x16){c0[0], c0[1], c0[2], c0[3], c1[0], c1[1], c1[2], c1[3], c2[0], c2[1], c2[2], c2[3], c3[0], c3[1], c3[2], c3[3]}; }
    const char* kb[4];
#pragma unroll
    for (int dd = 0; dd < 4; ++dd) kb[dd] = K_lds + KB * SHM_K + KSWZ(r32, (dd * 16 + hi * 8) * 2);
#pragma unroll
    for (int d0 = 0; d0 < 8; ++d0) { const char* a = kb[d0 & 3] + (d0 >> 2) * 128;
        bf16x8 b0 = *reinterpret_cast<const bf16x8*>(a);
        bf16x8 b1 = *reinterpret_cast<const bf16x8*>(a + 32 * 256);
        p0 = __builtin_amdgcn_mfma_f32_32x32x16_bf16(b0, qr[d0], p0, 0, 0, 0);
        p1 = __builtin_amdgcn_mfma_f32_32x32x16_bf16(b1, qr[d0], p1, 0, 0, 0); }
}
template <int VB>
__device__ __forceinline__ void pv_tile(f32x16* o, int vb0, bf16x8 pa0, bf16x8 pa1, bf16x8 pa2, bf16x8 pa3) {
#define TRRD(dst, off) asm volatile("ds_read_b64_tr_b16 %0, %1 offset:%2" : "=&v"(dst) : "v"(vb0), "i"(off) : "memory")
#define PV_D0(d0) do { s16x4 l0, l1, l2, l3, h0, h1, h2, h3; constexpr int b_ = VB * SHM_V + v_rd_off(d0, 0, 0); \
        TRRD(l0, b_); TRRD(h0, b_ + 2048); TRRD(l1, b_ + 4096); TRRD(h1, b_ + 6144); TRRD(l2, b_ + 8192); TRRD(h2, b_ + 10240); TRRD(l3, b_ + 12288); TRRD(h3, b_ + 14336); \
        asm volatile("s_waitcnt lgkmcnt(0)" ::: "memory"); SBAR();   \
        o[d0] = __builtin_amdgcn_mfma_f32_32x32x16_bf16(pa0, (bf16x8){l0[0], l0[1], l0[2], l0[3], h0[0], h0[1], h0[2], h0[3]}, o[d0], 0, 0, 0);   \
        o[d0] = __builtin_amdgcn_mfma_f32_32x32x16_bf16(pa1, (bf16x8){l1[0], l1[1], l1[2], l1[3], h1[0], h1[1], h1[2], h1[3]}, o[d0], 0, 0, 0);   \
        o[d0] = __builtin_amdgcn_mfma_f32_32x32x16_bf16(pa2, (bf16x8){l2[0], l2[1], l2[2], l2[3], h2[0], h2[1], h2[2], h2[3]}, o[d0], 0, 0, 0);   \
        o[d0] = __builtin_amdgcn_mfma_f32_32x32x16_bf16(pa3, (bf16x8){l3[0], l3[1], l3[2], l3[3], h3[0], h3[1], h3[2], h3[3]}, o[d0], 0, 0, 0); } while (0)
    PV_D0(0); PV_D0(1); PV_D0(2); PV_D0(3);
#undef PV_D0
#undef TRRD
}
struct BlockRef { unsigned qo, ko, vo, oo, bo; int P0; };
struct Rsrc { __amdgpu_buffer_rsrc_t proj, att, cum; };
__device__ __forceinline__ bf16x8 bload8(__amdgpu_buffer_rsrc_t r, unsigned voff, unsigned soff) { return __builtin_bit_cast(bf16x8, __builtin_amdgcn_raw_buffer_load_b128(r, voff, soff, 0)); }
struct Seam { bf16x8 qr[8]; bf16x8 st_v0, st_v1; };
#define VMW() asm volatile("s_waitcnt vmcnt(0)" ::: "memory")
#define VMWN(n) asm volatile("s_waitcnt vmcnt(%0)" :: "i"(n) : "memory")
#define SLOAD_H(R, k0, bf) do { const unsigned ks_ = (R).ko + (unsigned)(k0) * (LDQ * 2), vs_ = (R).vo + (unsigned)(k0) * (LDQ * 2); \
                         S.st_v0 = bload8(RS.proj, rowoff, vs_); S.st_v1 = bload8(RS.proj, rowoff, vs_ + 32 * LDQ * 2);              \
                         __builtin_amdgcn_raw_ptr_buffer_load_lds(RS.proj, (LAS void*)(ldsl + 2 * SHM_V + (bf) * SHM_K + wid * 2048), 16, koff0, ks_, 0, 0); \
                         __builtin_amdgcn_raw_ptr_buffer_load_lds(RS.proj, (LAS void*)(ldsl + 2 * SHM_V + (bf) * SHM_K + wid * 2048 + 1024), 16, koff1, ks_, 0, 0); \
                         if (wid == 0) __builtin_amdgcn_raw_ptr_buffer_load_lds(RS.cum, (LAS void*)(ldsl + OFF_BL + (bf) * 256), 4, (unsigned)lane * 4u, (R).bo + (unsigned)(k0) * 4u, 0, 0); } while (0)
#define KOFFS() const unsigned koff0 = (unsigned)((wid * 8 + (lane >> 4)) * LDQ + (((lane & 15) ^ ((lane >> 4) & 7)) * 8)) * 2u, \
                               koff1 = (unsigned)((wid * 8 + 4 + (lane >> 4)) * LDQ + (((lane & 15) ^ (((lane >> 4) + 4) & 7)) * 8)) * 2u
#define SWRITE_HV(bf) do { *(bf16x8*)(V_lds + (bf) * SHM_V + vst0) = S.st_v0; *(bf16x8*)(V_lds + (bf) * SHM_V + vst1) = S.st_v1; } while (0)
#define SWRITE_H(bf) SWRITE_HV(bf)
#define QLOAD(R) do { const unsigned qs_ = (R).qo + (unsigned)(wid * QBLK) * (LDQ * 2); _Pragma("unroll") for (int d0 = 0; d0 < 8; ++d0) S.qr[d0] = bload8(RS.proj, qoff + d0 * 32, qs_); } while (0)
__device__ __forceinline__ void fox_prime(const BlockRef& cur, const Rsrc& RS, char* lds, LAS unsigned char* ldsl, int wid, int lane, Seam& S) {
    const int tid = wid * 64 + lane, r32 = lane & 31, hi = lane >> 5;
    const unsigned rowoff = (unsigned)((tid >> 4) * LDQ + (tid & 15) * 8) * 2u, qoff = (unsigned)(r32 * LDQ + hi * 8) * 2u;
    KOFFS();
    QLOAD(cur);
    SLOAD_H(cur, 0, 0); VMW();
    __syncthreads();
}
__device__ __forceinline__ void fox_block(const BlockRef& cur, const BlockRef& nxt, const Rsrc& RS, char* lds, LAS unsigned char* ldsl, int wid, int lane, Seam& S) {
    const int tid = wid * 64 + lane, r32 = lane & 31, hi = lane >> 5;
    const int NT = (cur.P0 + QB - 1) / KVBLK + 1;
    const int qlo = cur.P0 + wid * QBLK;
    char* V_lds = lds; char* K_lds = lds + 2 * SHM_V; char* BL = lds + OFF_BL;
    float* ws = (float*)(lds + OFF_WS) + wid * 64; float* li_l = ws, * al_l = ws + 32;
    const unsigned rowoff = (unsigned)((tid >> 4) * LDQ + (tid & 15) * 8) * 2u, qoff = (unsigned)(r32 * LDQ + hi * 8) * 2u;
    float m_reg = -1e30f, l_reg = 0; f32x16 o[4] = {};
    const int sr = tid >> 4, sc = (tid & 15) * 8, vst0 = v_st(sr, sc), vst1 = v_st(32 + sr, sc);
    KOFFS();
    const int vb0 = (int)(uintptr_t)V_lds + v_rd_base(lane);
#define RESC(a) do { if (__any((a) < 1.f)) { int l_; asm volatile("v_mbcnt_lo_u32_b32 %0, -1, 0\n\tv_mbcnt_hi_u32_b32 %0, -1, %0" : "=v"(l_)); l_ &= 63; const int h_ = l_ >> 5; \
                     if (h_ == 0) al_l[l_ & 31] = (a); asm volatile("s_waitcnt lgkmcnt(0)" ::: "memory");              \
                     for (int d_ = 0; d_ < 4; ++d_) for (int r = 0; r < 16; ++r) o[d_][r] *= al_l[crow(r, h_)]; } } while (0)
#define KBASE(t) ((t) * KVBLK)
#define MASKT(P0_, P1_, t) do { const int kb_ = KBASE(t); if (kb_ + KVBLK - 1 > qlo) { int l_; asm volatile("v_mbcnt_lo_u32_b32 %0, -1, 0\n\tv_mbcnt_hi_u32_b32 %0, -1, %0" : "=v"(l_)); l_ &= 63; \
        mask_tile(P0_, P1_, qlo + (l_ & 31) - 4 * (l_ >> 5) - kb_); } } while (0)
    constexpr int NQL = 8;
#define SEAM_K0() do { VMWN(NQL); SBAR(); } while (0)
    f32x16 pA0, pA1, pB0, pB1; float mnA, mnB, alA, alB; bf16x8 pa0, pa1, pa2, pa3;
    SWRITE_HV(0); SBAR();
    if (NT > 1) { SLOAD_H(cur, KBASE(1), 1); }
    SBAR(); qkt<0>(pA0, pA1, K_lds, BL, r32, hi, S.qr);
    MASKT(pA0, pA1, 0); partialSM(pA0, pA1, m_reg, mnA, alA);
    if (NT > 1) { VMW(); SWRITE_H(1); }
    __syncthreads();
#define HALF_STEP(PX0, PX1, mnX, alX, PY0, PY1, alY, t, KB, VB, SB) do {                                                      \
        SBAR(); qkt<KB>(PX0, PX1, K_lds, BL, r32, hi, S.qr);                                             \
        finishSM(PY0, PY1, alY, l_reg, pa0, pa1, pa2, pa3); SBAR();                                                           \
        if ((t) + 1 < NT) { SLOAD_H(cur, KBASE((t) + 1), SB); SBAR(); }                                               \
        pv_tile<VB>(o, vb0, pa0, pa1, pa2, pa3); MASKT(PX0, PX1, (t)); partialSM(PX0, PX1, m_reg, mnX, alX);                                        \
        __syncthreads();                                                                                                      \
        if ((t) + 1 < NT) { VMW(); SWRITE_H(SB); }                                                                          \
        RESC(alX); __syncthreads(); } while (0)
    for (int t = 1; t + 1 < NT; t += 2) {
        HALF_STEP(pB0, pB1, mnB, alB, pA0, pA1, alA, t, 1, 0, 0);
        HALF_STEP(pA0, pA1, mnA, alA, pB0, pB1, alB, t + 1, 0, 1, 1);
    }
    const bool even = (NT & 1) == 0;
    if (even) { SBAR(); qkt<1>(pB0, pB1, K_lds, BL, r32, hi, S.qr); SBAR(); }
    SLOAD_H(nxt, 0, 0); SBAR();
    QLOAD(nxt);
    SBAR();
    finishSM(pA0, pA1, alA, l_reg, pa0, pa1, pa2, pa3); SBAR();
    pv_tile<0>(o, vb0, pa0, pa1, pa2, pa3);
    if (even) { MASKT(pB0, pB1, NT - 1); partialSM(pB0, pB1, m_reg, mnB, alB); __syncthreads(); RESC(alB);
        finishSM(pB0, pB1, alB, l_reg, pa0, pa1, pa2, pa3); SBAR(); pv_tile<1>(o, vb0, pa0, pa1, pa2, pa3); }
    SBAR(); SEAM_K0();
    if (hi == 0) li_l[r32] = l_reg; asm volatile("s_waitcnt lgkmcnt(0)" ::: "memory");
    float rli[16];
#pragma unroll
    for (int r = 0; r < 16; ++r) rli[r] = __builtin_amdgcn_rcpf(li_l[crow(r, hi)]);
    const unsigned os_ = cur.oo + (unsigned)(wid * QBLK) * (LDO * 2), ov_ = (unsigned)(4 * hi * LDO + r32) * 2u;
#pragma unroll
    for (int r = 0; r < 16; ++r) { const int orc = (r & 3) + 8 * (r >> 2);
#pragma unroll
        for (int d0 = 0; d0 < 4; ++d0) { const float v = o[d0][r] * rli[r];
            const float vn = __shfl_xor(v, 1);
            if ((r32 & 1) == 0) __builtin_amdgcn_raw_buffer_store_b32(cvtpk(v, vn), RS.att, ov_, os_ + (unsigned)(orc * LDO + d0 * 32) * 2u, 0); } }
    __syncthreads();
#undef RESC
#undef KBASE
#undef MASKT
#undef SEAM_K0
#undef HALF_STEP
}
#undef QLOAD
#undef VMW
#undef VMWN
#undef SLOAD_H
#undef KOFFS
#undef SWRITE_HV
#undef SWRITE_H
#undef KSWZ
#undef SBAR
}

struct Frame {
    LAS unsigned char* lds;
    int wave, vcu, G;
    unsigned char* ws;
};
__device__ __forceinline__ int lane_id_v() { int l; asm volatile("v_mbcnt_lo_u32_b32 %0, -1, 0\n\tv_mbcnt_hi_u32_b32 %0, -1, %0" : "=v"(l)); return l & 63; }
__device__ __forceinline__ float wave_sum(float v) {
#pragma unroll
    for (int o = 1; o < 64; o <<= 1) v += __shfl_xor(v, o);
    return v;
}

__device__ __forceinline__ void transpose_item(const float* W, int ldw, int k0, int n0, int nvalid, bf16_t* WT, int ldt, int drow0, LAS float* scr, int lane) {
    const int nn = (lane & 31) < nvalid ? (lane & 31) : (nvalid - 1);
#pragma unroll 8
    for (int i = 0; i < 32; ++i) { const int kk = 2 * i + (lane >> 5); scr[kk * 33 + (lane & 31)] = W[(size_t)(k0 + kk) * ldw + n0 + nn]; }
    LDS_WAIT(); asm volatile("" ::: "memory");
    const int c = lane & 7;
#pragma unroll
    for (int j = 0; j < 4; ++j) { const int n = (lane >> 3) + 8 * j; const LAS float* s = scr + (8 * c) * 33 + n;
        u32x4 o; o.x = cvt_pk_bf16(s[0 * 33], s[1 * 33]); o.y = cvt_pk_bf16(s[2 * 33], s[3 * 33]); o.z = cvt_pk_bf16(s[4 * 33], s[5 * 33]); o.w = cvt_pk_bf16(s[6 * 33], s[7 * 33]);
        if (n >= nvalid) o = (u32x4){0u, 0u, 0u, 0u};
        *(u32x4*)(WT + (size_t)(drow0 + n) * ldt + k0 + 8 * c) = o; }
    LDS_WAIT(); asm volatile("" ::: "memory");
}
__device__ __forceinline__ int win_row(int n0) {
    if (n0 < 6656) return n0;
    if (n0 < 6784) return 12800 + SM_KI + (n0 - 6656);
    if (n0 < 6816) return 12800 + SM_WI + (n0 - 6784);
    if (n0 < 12960) return 6656 + (n0 - 6816);
    return 12800 + SM_FB + (n0 - 12960);
}
__device__ __forceinline__ void convert_ffn(Frame& F, const float* wg, const float* wu, const float* wd) {
    const int lane = lane_id_v();
    LAS float* scr = (LAS float*)(F.lds + F.wave * 16384);
    bf16_t* W1 = (bf16_t*)(F.ws + WS_W1); bf16_t* WD = (bf16_t*)(F.ws + WS_WD);
    const int gw = F.vcu * NWAVES + F.wave, NGW = F.G * NWAVES;
    constexpr int I_G = (DM / 64) * (DFF / 32), I_D = (DFF / 64) * (DM / 32);
    for (int it = gw; it < 2 * I_G + I_D; it += NGW) {
        int r = it;
        if (r < 2 * I_G) { const int up = r >= I_G; if (up) r -= I_G; const int nblk = DFF / 32, kb = r / nblk, nb = r % nblk, n0 = nb * 32;
            transpose_item(up ? wu : wg, DFF, kb * 64, n0, 32, W1, DM, (n0 >> 7) * 256 + (n0 & 127) + (up ? 128 : 0), scr, lane); continue; }
        r -= 2 * I_G;
        { const int nblk = DM / 32, kb = r / nblk, nb = r % nblk; transpose_item(wd, DM, kb * 64, nb * 32, 32, WD, DFF, nb * 32, scr, lane); }
    }
}
__device__ __forceinline__ void convert_misc(Frame& F, int cidx, int ccount, const float* w_in, const float* w_out, const float* w_uk, const float* w_uv) {
    const int lane = lane_id_v(), tid = F.wave * 64 + lane;
    LAS float* scr = (LAS float*)(F.lds + F.wave * 16384);
    bf16_t* WIN = (bf16_t*)(F.ws + WS_WIN); bf16_t* WOUT = (bf16_t*)(F.ws + WS_WOUT); bf16_t* WUK = (bf16_t*)(F.ws + WS_WUK); bf16_t* WUV = (bf16_t*)(F.ws + WS_WUV);
    const int gw = cidx * NWAVES + F.wave, NGW = ccount * NWAVES;
    constexpr int NBI = (DIN + 31) / 32;
    constexpr int I_IN = (DM / 64) * NBI, I_OUT = (DM / 64) * (DM / 32), I_UK = NH * (HD / 64) * (DLAT / 32), I_UV = NH * (DLAT / 64) * (HD / 32);
    for (int it = gw; it < I_IN + I_OUT + I_UK + I_UV; it += NGW) {
        int r = it;
        if (r < I_IN) { const int kb = r / NBI, nb = r % NBI, n0 = nb * 32; const int nv = (DIN - n0) < 32 ? (DIN - n0) : 32;
            transpose_item(w_in, DIN, kb * 64, n0, nv, WIN, DM, win_row(n0), scr, lane); continue; }
        r -= I_IN;
        if (r < I_OUT) { const int nblk = DM / 32, kb = r / nblk, nb = r % nblk; transpose_item(w_out, DM, kb * 64, nb * 32, 32, WOUT, DM, nb * 32, scr, lane); continue; }
        r -= I_OUT;
        if (r < I_UK) { const int per = (HD / 64) * (DLAT / 32), h = r / per, q = r % per, kb = q / (DLAT / 32), nb = q % (DLAT / 32);
            transpose_item(w_uk + (size_t)h * HD * DLAT, DLAT, kb * 64, nb * 32, 32, WUK, 256, h * DLAT + nb * 32, scr, lane); continue; }
        r -= I_UK;
        { const int per = (DLAT / 64) * (HD / 32), h = r / per, q = r % per, kb = q / (HD / 32), nb = q % (HD / 32);
            transpose_item(w_uv + (size_t)h * DLAT * HD, HD, kb * 64, nb * 32, 32, WUV, DLAT, h * HD + nb * 32, scr, lane); }
    }
    const int gt = cidx * (NWAVES * 64) + tid, NGT = ccount * NWAVES * 64;
    const u32x4 z = (u32x4){0u, 0u, 0u, 0u};
    for (int i = gt; i < (DINP - 12992) * (DM / 8); i += NGT) *(u32x4*)(WIN + (size_t)12992 * DM + (size_t)i * 8) = z;
    for (int i = gt; i < NH * DLAT * 16; i += NGT) { const int row = i >> 4, c = i & 15; *(u32x4*)(WUK + (size_t)row * 256 + 128 + c * 8) = z; }
    for (int i = gt; i < 128 * (DLAT / 8); i += NGT) *(u32x4*)(WUV + (size_t)2048 * DLAT + (size_t)i * 8) = z;
}
__device__ __forceinline__ void convert_x(Frame& F, const float* x) {
    const int tid = F.wave * 64 + lane_id_v();
    const int gt = F.vcu * (NWAVES * 64) + tid, NGT = F.G * NWAVES * 64;
    bf16_t* XB = (bf16_t*)(F.ws + WS_XB);
    for (size_t i = gt; i < (size_t)M * DM / 8; i += NGT) { const f32x4 a = *(const f32x4*)(x + i * 8), b = *(const f32x4*)(x + i * 8 + 4);
        u32x4 w; w.x = cvt_pk_bf16(a[0], a[1]); w.y = cvt_pk_bf16(a[2], a[3]); w.z = cvt_pk_bf16(b[0], b[1]); w.w = cvt_pk_bf16(b[2], b[3]); *(u32x4*)(XB + i * 8) = w; }
}

template <bool OUT_F32>
__device__ __forceinline__ void ln_phase(Frame& F, const bf16_t* pre, const float* g, const float* b, void* out) {
    const int lane = lane_id_v();
    const int gw = F.vcu * NWAVES + F.wave, NGW = F.G * NWAVES;
    for (int m = gw; m < M; m += NGW) {
        const u32x4* xr = (const u32x4*)(pre + (size_t)m * DM) + lane;
        f32x4 v[16]; float s = 0.f;
#pragma unroll
        for (int j = 0; j < 8; ++j) { const u32x4 w = xr[64 * j]; v[2 * j] = (f32x4){bflo(w.x), bfhi(w.x), bflo(w.y), bfhi(w.y)}; v[2 * j + 1] = (f32x4){bflo(w.z), bfhi(w.z), bflo(w.w), bfhi(w.w)};
            s += ((v[2 * j].x + v[2 * j].y) + (v[2 * j].z + v[2 * j].w)) + ((v[2 * j + 1].x + v[2 * j + 1].y) + (v[2 * j + 1].z + v[2 * j + 1].w)); }
        const float mean = wave_sum(s) * (1.f / DM); float s2 = 0.f;
#pragma unroll
        for (int j = 0; j < 16; ++j) { v[j] = v[j] - mean; s2 += (v[j].x * v[j].x + v[j].y * v[j].y) + (v[j].z * v[j].z + v[j].w * v[j].w); }
        const float rstd = 1.f / __builtin_sqrtf(wave_sum(s2) * (1.f / DM) + LN_EPS);
#pragma unroll
        for (int j = 0; j < 8; ++j) {
            const f32x4 g0 = ((const f32x4*)g)[(64 * j + lane) * 2], g1 = ((const f32x4*)g)[(64 * j + lane) * 2 + 1], b0 = ((const f32x4*)b)[(64 * j + lane) * 2], b1 = ((const f32x4*)b)[(64 * j + lane) * 2 + 1];
            const f32x4 y0 = v[2 * j] * rstd * g0 + b0, y1 = v[2 * j + 1] * rstd * g1 + b1;
            if constexpr (OUT_F32) { f32x4* o = (f32x4*)((float*)out + (size_t)m * DM) + (64 * j + lane) * 2; o[0] = y0; o[1] = y1; }
            else { u32x4 w; w.x = cvt_pk_bf16(y0.x, y0.y); w.y = cvt_pk_bf16(y0.z, y0.w); w.z = cvt_pk_bf16(y1.x, y1.y); w.w = cvt_pk_bf16(y1.z, y1.w); ((u32x4*)((bf16_t*)out + (size_t)m * DM))[64 * j + lane] = w; }
        }
    }
}

__device__ __forceinline__ void p5_norms(Frame& F, const float* kv_g, const float* ik_g, const float* ik_b, const float* b_f) {
    const float* CKVRAW = (const float*)(F.ws + WS_CKVRAW); const float* SMALL = (const float*)(F.ws + WS_SMALL);
    bf16_t* CKV = (bf16_t*)(F.ws + WS_CKV); bf16_t* KI = (bf16_t*)(F.ws + WS_KI); float* CUMK = (float*)(F.ws + WS_CUMK);
    const int gw = F.vcu * NWAVES + F.wave, NGW = F.G * NWAVES, lane = lane_id_v();
    if (gw < NB * NH) {
        const int b = gw / NH, h = gw % NH; const float bf = b_f[h];
        const float* src = SMALL + (size_t)(b * SEQ + lane * 64) * 256 + SM_FB + h;
        double tot = 0.0;
        for (int i = 0; i < 64; ++i) { const float z = src[(size_t)i * 256] + bf; const float lf = fminf(z, 0.f) - log1pf(expf(-fabsf(z))); tot += (double)lf; }
        double incl = tot;
#pragma unroll
        for (int o = 1; o < 64; o <<= 1) { const double t = __shfl_up(incl, o); if (lane >= o) incl += t; }
        double run = incl - tot;
        float* dst = CUMK + (size_t)gw * SEQ + lane * 64;
        for (int i = 0; i < 64; ++i) { const float z = src[(size_t)i * 256] + bf; const float lf = fminf(z, 0.f) - log1pf(expf(-fabsf(z))); run += (double)lf;
            dst[i] = (float)(-run * 11.313708498984761); }
    }
    for (int m = gw; m < M; m += NGW) {
        {
            const f32x4 a = *(const f32x4*)(CKVRAW + (size_t)m * DLAT + lane * 8), c = *(const f32x4*)(CKVRAW + (size_t)m * DLAT + lane * 8 + 4);
            const float ss = wave_sum((a.x * a.x + a.y * a.y) + (a.z * a.z + a.w * a.w) + (c.x * c.x + c.y * c.y) + (c.z * c.z + c.w * c.w));
            const float r = 1.f / __builtin_sqrtf(ss * (1.f / DLAT) + RMS_EPS);
            const f32x4 g0 = *(const f32x4*)(kv_g + lane * 8), g1 = *(const f32x4*)(kv_g + lane * 8 + 4);
            u32x4 w; w.x = cvt_pk_bf16(a.x * r * g0.x, a.y * r * g0.y); w.y = cvt_pk_bf16(a.z * r * g0.z, a.w * r * g0.w);
            w.z = cvt_pk_bf16(c.x * r * g1.x, c.y * r * g1.y); w.w = cvt_pk_bf16(c.z * r * g1.z, c.w * r * g1.w);
            *(u32x4*)(CKV + (size_t)m * DLAT + lane * 8) = w;
        }
        {
            const f32x2 v = *(const f32x2*)(SMALL + (size_t)m * 256 + SM_KI + lane * 2);
            const float mean = wave_sum(v.x + v.y) * (1.f / IDIM); const float d0 = v.x - mean, d1 = v.y - mean;
            const float r = 1.f / __builtin_sqrtf(wave_sum(d0 * d0 + d1 * d1) * (1.f / IDIM) + LN_EPS);
            const f32x2 g = *(const f32x2*)(ik_g + lane * 2), bb = *(const f32x2*)(ik_b + lane * 2);
            *(unsigned*)(KI + (size_t)m * IDIM + lane * 2) = cvt_pk_bf16(d0 * r * g.x + bb.x, d1 * r * g.y + bb.y);
        }
    }
}

__device__ __forceinline__ fox::BlockRef fox_ref(int bh, int qb) {
    const int b = bh / NH, h = bh % NH; fox::BlockRef r;
    r.qo = (unsigned)(((size_t)(b * SEQ + qb * 256) * PROJW + PC_QB + h * HD) * 2);
    r.ko = (unsigned)(((size_t)(b * SEQ) * PROJW + PC_KB + h * HD) * 2); r.vo = (unsigned)(((size_t)(b * SEQ) * PROJW + PC_VB + h * HD) * 2);
    r.oo = (unsigned)(((size_t)(b * SEQ + qb * 256) * DM + 2048 + h * HD) * 2); r.bo = (unsigned)(bh * SEQ * 4); r.P0 = qb * 256;
    return r;
}
__device__ __forceinline__ void fox_phase(Frame& F, char* lds) {
    constexpr int NQB = SEQ / 256, NX = NQB / 2, TOTAL = NB * NH * NX;
    const int lane = lane_id_v();
    int L = F.vcu; if (L >= TOTAL) return;
    int pass = 0;
    fox::Rsrc RS;
    RS.proj = __builtin_amdgcn_make_buffer_rsrc((void*)(F.ws + WS_PROJ), 0, 0x7ffffffc, 0x00020000);
    RS.att = __builtin_amdgcn_make_buffer_rsrc((void*)(F.ws + WS_ATT), 0, 0x7ffffffc, 0x00020000);
    RS.cum = __builtin_amdgcn_make_buffer_rsrc((void*)(F.ws + WS_CUMK), 0, 0x7ffffffc, 0x00020000);
    fox::BlockRef cur = fox_ref(L / NX, L % NX);
    fox::Seam S;
    fox::fox_prime(cur, RS, lds, F.lds, F.wave, lane, S);
    for (;;) {
        const bool more_pass = pass == 0, more_item = L + F.G < TOTAL, last = !more_pass && !more_item;
        int Ln = L, passn = pass + 1;
        if (!more_pass) { passn = 0; Ln = more_item ? L + F.G : L; }
        const int yn = Ln % NX;
        const fox::BlockRef nxt = last ? cur : fox_ref(Ln / NX, passn ? NQB - 1 - yn : yn);
        fox::fox_block(cur, nxt, RS, lds, F.lds, F.wave, lane, S);
        if (last) break;
        cur = nxt; pass = passn; L = Ln;
    }
}

constexpr int IDX_QT = 0;
__device__ __forceinline__ void indexer_phase(Frame& F) {
    const bf16_t* KI = (const bf16_t*)(F.ws + WS_KI);
    const float* SMALL = (const float*)(F.ws + WS_SMALL); float* SCORES = (float*)(F.ws + WS_SCORES);
    const __amdgpu_buffer_rsrc_t rp = __builtin_amdgcn_make_buffer_rsrc((void*)(F.ws + WS_PROJ), 0, 0x7ffffffc, 0x00020000);
    const int lane = lane_id_v(), wid = F.wave, r32 = lane & 31, hi = lane >> 5, wq = wid >> 1, wk = wid & 1;
    constexpr int UPB = 525, NU = NB * UPB;
    constexpr float WS = 0.17677669529663687f * 0.08838834764831845f;
    unsigned dsrc[4];
#pragma unroll
    for (int i = 0; i < 4; ++i) { const int row = 16 * wid + 4 * i + (lane >> 4); dsrc[i] = (unsigned)(row * PROJW + (((lane & 15) ^ (row & 7)) * 8)) * 2u; }
    const int qrow = wq * 32 + r32;
    unsigned kb[4];
#pragma unroll
    for (int dd = 0; dd < 4; ++dd) kb[dd] = (unsigned)(uintptr_t)F.lds + IDX_QT + (unsigned)(qrow * 256 + (((dd * 16 + hi * 8) * 2) ^ ((qrow & 7) << 4)));
#define IDX_DMA(hp, st) do { _Pragma("unroll") for (int e = 0; e < 2; ++e) { const unsigned so_ = qsoff + (unsigned)(2 * (hp) + e) * (IDIM * 2); _Pragma("unroll") for (int i = 0; i < 4; ++i) \
        __builtin_amdgcn_raw_ptr_buffer_load_lds(rp, (LAS void*)(F.lds + IDX_QT + (2 * (st) + e) * 32768 + wid * 4096 + i * 1024), 16, dsrc[i], so_, 0, 0); } } while (0)
#define IDX_HEAD(bo, w) do { bf16x8 qb[8]; _Pragma("unroll") for (int d0 = 0; d0 < 8; ++d0) qb[d0] = *(const LAS bf16x8*)(kb[d0 & 3] + (bo) + (d0 >> 2) * 128); \
        f32x16 a0 = {}, a1 = {}; \
        _Pragma("unroll") for (int kk = 0; kk < 8; ++kk) { a0 = __builtin_amdgcn_mfma_f32_32x32x16_bf16(ka[0][kk], qb[kk], a0, 0, 0, 0); a1 = __builtin_amdgcn_mfma_f32_32x32x16_bf16(ka[1][kk], qb[kk], a1, 0, 0, 0); } \
        _Pragma("unroll") for (int r_ = 0; r_ < 16; ++r_) { sc0[r_] = fmaf((w), fmaxf(a0[r_], 0.f), sc0[r_]); sc1[r_] = fmaf((w), fmaxf(a1[r_], 0.f), sc1[r_]); } } while (0)
    for (int u = F.vcu; u < NU; u += F.G) {
        const int b = u / UPB; int r = u % UPB, qt = 2; while (r >= qt + 1) { r -= qt + 1; ++qt; } const int kt = r;
        const int qbase = b * SEQ + qt * 128, q0 = qbase + wq * 32, key0 = b * SEQ + kt * 128 + wk * 64;
        const unsigned qsoff = (unsigned)(((size_t)qbase * PROJW + PC_QI) * 2);
        IDX_DMA(0, 0); IDX_DMA(1, 1);
        const float* wp = SMALL + (size_t)(q0 + r32) * 256 + SM_WI;
        f32x2 wn = *(const f32x2*)wp;
        bf16x8 ka[2][8];
#pragma unroll
        for (int mb = 0; mb < 2; ++mb)
#pragma unroll
            for (int kk = 0; kk < 8; ++kk) ka[mb][kk] = *(const bf16x8*)(KI + (size_t)(key0 + 32 * mb + r32) * IDIM + 16 * kk + 8 * hi);
        f32x16 sc0 = {}, sc1 = {};
        asm volatile("s_waitcnt vmcnt(0)" ::: "memory");
        __syncthreads();
#pragma unroll 1
        for (int hp = 0; hp < NIH / 2; ++hp) {
            const unsigned bo = (unsigned)(hp & 1) * 65536u;
            const f32x2 wc = wn * WS;
            if (hp + 1 < NIH / 2) wn = *(const f32x2*)(wp + 2 * hp + 2);
            IDX_HEAD(bo, wc.x);
            IDX_HEAD(bo + 32768u, wc.y);
            asm volatile("s_waitcnt vmcnt(0)" ::: "memory");
            __syncthreads();
            if (hp + 2 < NIH / 2) IDX_DMA(hp + 2, hp & 1);
        }
        float* op = SCORES + (size_t)(q0 + r32) * SEQ + kt * 128 + wk * 64 + 4 * hi;
#pragma unroll
        for (int g = 0; g < 4; ++g) {
            *(f32x4*)(op + 8 * g) = (f32x4){sc0[4 * g], sc0[4 * g + 1], sc0[4 * g + 2], sc0[4 * g + 3]};
            *(f32x4*)(op + 32 + 8 * g) = (f32x4){sc1[4 * g], sc1[4 * g + 1], sc1[4 * g + 2], sc1[4 * g + 3]};
        }
    }
#undef IDX_DMA
#undef IDX_HEAD
}

template <int NR>
__device__ __forceinline__ void topk_row(const float* srow, int nreg, int* out, int lane) {
    unsigned key[NR];
#pragma unroll
    for (int j = 0; j < NR; ++j) {
        unsigned k = 0u;
        if (j < nreg) { const unsigned u = __float_as_uint(srow[j * 64 + lane]); k = (u & 0x80000000u) ? ~u : (u | 0x80000000u); }
        key[j] = k;
    }
    unsigned T = 0u;
    for (int bit = 31; bit >= 0; --bit) {
        const unsigned cand = T | (1u << bit); int c = 0;
#pragma unroll
        for (int j = 0; j < NR; ++j) c += (key[j] >= cand) ? 1 : 0;
#pragma unroll
        for (int o = 1; o < 64; o <<= 1) c += __shfl_xor(c, o);
        if (c >= TOPK) T = cand;
    }
    int cgt = 0;
#pragma unroll
    for (int j = 0; j < NR; ++j) cgt += (key[j] > T) ? 1 : 0;
#pragma unroll
    for (int o = 1; o < 64; o <<= 1) cgt += __shfl_xor(cgt, o);
    int bg = 0, be = cgt;
    unsigned T2 = T; asm volatile("" : "+v"(T2));
#pragma unroll
    for (int j = 0; j < NR; ++j) {
        const bool gt = key[j] > T2, eq = key[j] == T2;
        const unsigned long long mg = __ballot(gt), me = __ballot(eq);
        const int pg = bg + (int)__builtin_amdgcn_mbcnt_hi((unsigned)(mg >> 32), __builtin_amdgcn_mbcnt_lo((unsigned)mg, 0u));
        const int pe = be + (int)__builtin_amdgcn_mbcnt_hi((unsigned)(me >> 32), __builtin_amdgcn_mbcnt_lo((unsigned)me, 0u));
        if (gt) out[pg] = j * 64 + lane;
        if (eq && pe < TOPK) out[pe] = j * 64 + lane;
        bg += __popcll(mg); be += __popcll(me);
        __builtin_amdgcn_sched_barrier(0);
    }
}
__device__ __forceinline__ void topk_phase(Frame& F) {
    const float* SCORES = (const float*)(F.ws + WS_SCORES); int* IDX = (int*)(F.ws + WS_IDX);
    const int gw = F.vcu * NWAVES + F.wave, NGW = F.G * NWAVES, lane = lane_id_v();
    for (int row = gw; row < M; row += NGW) {
        const int t = row % SEQ, nreg = (t >> 6) + 1;
        int* out = IDX + (size_t)row * TOPK;
        if (nreg <= 4) { *(i32x4*)(out + lane * 4) = (i32x4){lane * 4, lane * 4 + 1, lane * 4 + 2, lane * 4 + 3}; continue; }
        const float* srow = SCORES + (size_t)row * SEQ;
        if (nreg <= 16) topk_row<16>(srow, nreg, out, lane);
        else if (nreg <= 32) topk_row<32>(srow, nreg, out, lane);
        else topk_row<64>(srow, nreg, out, lane);
    }
}

constexpr int DSA_TILE = 32 * 544, DSA_TAB = NWAVES * DSA_TILE;
__device__ __forceinline__ void dsa_phase(Frame& F, const float* rel_bias) {
    const bf16_t* CKV = (const bf16_t*)(F.ws + WS_CKV); bf16_t* QLAT = (bf16_t*)(F.ws + WS_QLAT); const int* IDX = (const int*)(F.ws + WS_IDX);
    LAS float* relb = (LAS float*)(F.lds + DSA_TAB); LAS int* lut = (LAS int*)(F.lds + DSA_TAB + 2048);
    const int lane = lane_id_v(), tid = F.wave * 64 + lane;
    for (int i = tid; i < 512; i += NWAVES * 64) relb[i] = rel_bias[i];
    if (tid < 128) { const int n = tid; lut[n] = n < 8 ? n : n < 12 ? 8 : n < 16 ? 9 : n < 23 ? 10 : n < 32 ? 11 : n < 46 ? 12 : n < 64 ? 13 : n < 91 ? 14 : 15; }
    __syncthreads();
    const int head = lane & 15, g = lane >> 4;
    const bool xdeal = (F.G == 256);
    const int xw = (F.vcu & 31) * NWAVES + F.wave, xbase = (F.vcu >> 5) * 2048;
    const int gw = xdeal ? xbase + xw : F.vcu * NWAVES + F.wave, NGW = xdeal ? 256 : F.G * NWAVES, rend = xdeal ? xbase + 2048 : M;
    LAS unsigned char* tile = F.lds + F.wave * DSA_TILE;
    const unsigned trbase = (unsigned)(uintptr_t)tile + (unsigned)((4 * g + ((lane & 15) >> 2)) * 544 + (lane & 3) * 8);
    const unsigned stw = (unsigned)(uintptr_t)tile + (unsigned)((lane >> 5) * 544 + (lane & 31) * 16);
    for (int row = gw; row < rend; row += NGW) {
        const int b = row / SEQ, t = row % SEQ; const int L = ((t >> 6) + 1) * 64, nsel = L < TOPK ? L : TOPK, ng = nsel >> 4;
        const int* irow = IDX + (size_t)row * TOPK;
        const __amdgpu_buffer_rsrc_t rc = __builtin_amdgcn_make_buffer_rsrc((void*)(CKV + (size_t)b * SEQ * DLAT), 0, SEQ * DLAT * 2, 0x00020000);
        const __amdgpu_buffer_rsrc_t rq = __builtin_amdgcn_make_buffer_rsrc((void*)(QLAT + (size_t)row * NH * DLAT), 0, NH * DLAT * 2, 0x00020000);
        f32x4 lg[16];
#pragma unroll
        for (int grp = 0; grp < 16; ++grp) lg[grp] = (f32x4){0.f, 0.f, 0.f, 0.f};
        const unsigned rdbase = (unsigned)(uintptr_t)tile + (unsigned)((lane & 15) * 544 + g * 16);
        const unsigned qo = (unsigned)(head * DLAT + 8 * g) * 2u;
#define DSA_G(kb, ho_) do { const int ridx_ = (32 * (kb) < nsel) ? irow[32 * (kb) + (lane & 31)] : 0; _Pragma("unroll") for (int i = 0; i < 16; ++i) { const int s_ = __shfl(ridx_, 2 * i + (lane >> 5)); v[i] = fox::bload8(rc, (unsigned)(s_ * DLAT) * 2u + (ho_), 0); } } while (0)
#pragma unroll 1
        for (int half = 0; half < 2; ++half) {
            bf16x8 qf[8], v[16];
#pragma unroll
            for (int kk = 0; kk < 8; ++kk) qf[kk] = fox::bload8(rq, qo + (unsigned)(half * 512 + kk * 64), 0);
            const unsigned ho = (unsigned)(half * 256 + (lane & 31) * 8) * 2u;
            DSA_G(0, ho);
#pragma unroll
            for (int kb = 0; kb < 8; ++kb) {
#pragma unroll
                for (int i = 0; i < 16; ++i) *(LAS bf16x8*)(stw + i * 1088) = v[i];
                if (kb + 1 < 8) DSA_G(kb + 1, ho);
#pragma unroll
                for (int kk = 0; kk < 8; ++kk) {
                    const bf16x8 a0 = *(const LAS bf16x8*)(rdbase + kk * 64), a1 = *(const LAS bf16x8*)(rdbase + 16 * 544 + kk * 64);
                    lg[2 * kb] = __builtin_amdgcn_mfma_f32_16x16x32_bf16(a0, qf[kk], lg[2 * kb], 0, 0, 0);
                    lg[2 * kb + 1] = __builtin_amdgcn_mfma_f32_16x16x32_bf16(a1, qf[kk], lg[2 * kb + 1], 0, 0, 0);
                }
            }
        }
#pragma unroll
        for (int grp = 0; grp < 16; ++grp) {
            const bool live = grp < ng;
            i32x4 sk = *(const i32x4*)(irow + grp * 16 + 4 * g);
#pragma unroll
            for (int i = 0; i < 4; ++i) { const int rel = live ? sk[i] - t : 0, n = rel < 0 ? -rel : rel; const int bk = lut[n < 127 ? n : 127] + (rel > 0 ? 16 : 0);
                const float v_ = lg[grp][i] * 0.08838834764831845f + relb[bk * 16 + head]; lg[grp][i] = live ? v_ : -1e30f; }
        }
        float mx = -1e30f;
#pragma unroll
        for (int grp = 0; grp < 16; ++grp) mx = fmaxf(fmaxf(mx, fmaxf(lg[grp][0], lg[grp][1])), fmaxf(lg[grp][2], lg[grp][3]));
        mx = fmaxf(mx, __shfl_xor(mx, 16)); mx = fmaxf(mx, __shfl_xor(mx, 32));
        float sum = 0.f;
#pragma unroll
        for (int grp = 0; grp < 16; ++grp)
#pragma unroll
            for (int i = 0; i < 4; ++i) { const float e = __builtin_amdgcn_exp2f((lg[grp][i] - mx) * 1.4426950408889634f); lg[grp][i] = e; sum += e; }
        sum += __shfl_xor(sum, 16); sum += __shfl_xor(sum, 32);
        const float inv = 1.f / sum;
        bf16x8 pb[8];
#pragma unroll
        for (int kb = 0; kb < 8; ++kb) { u32x4 w; w.x = cvt_pk_bf16(lg[2 * kb][0] * inv, lg[2 * kb][1] * inv); w.y = cvt_pk_bf16(lg[2 * kb][2] * inv, lg[2 * kb][3] * inv);
            w.z = cvt_pk_bf16(lg[2 * kb + 1][0] * inv, lg[2 * kb + 1][1] * inv); w.w = cvt_pk_bf16(lg[2 * kb + 1][2] * inv, lg[2 * kb + 1][3] * inv); pb[kb] = *reinterpret_cast<bf16x8*>(&w); }
#pragma unroll 1
        for (int half = 0; half < 2; ++half) {
            f32x4 oacc[16];
#pragma unroll
            for (int mb = 0; mb < 16; ++mb) oacc[mb] = (f32x4){0.f, 0.f, 0.f, 0.f};
            bf16x8 v[16];
            const unsigned ho = (unsigned)(half * 256 + (lane & 31) * 8) * 2u;
            DSA_G(0, ho);
#pragma unroll
            for (int kb = 0; kb < 8; ++kb) {
                {
#pragma unroll
                    for (int i = 0; i < 16; ++i) *(LAS bf16x8*)(stw + i * 1088) = v[i];
                    if (kb + 1 < 8) DSA_G(kb + 1, ho);
                    if (2 * kb < ng)
#pragma unroll
                    for (int mb = 0; mb < 16; ++mb) {
                        const s16x4 lo = __builtin_bit_cast(s16x4, __builtin_amdgcn_ds_read_tr16_b64_v4i16((LAS s16x4*)(trbase + mb * 32)));
                        const s16x4 hi4 = __builtin_bit_cast(s16x4, __builtin_amdgcn_ds_read_tr16_b64_v4i16((LAS s16x4*)(trbase + 16 * 544 + mb * 32)));
                        oacc[mb] = __builtin_amdgcn_mfma_f32_16x16x32_bf16((bf16x8){lo[0], lo[1], lo[2], lo[3], hi4[0], hi4[1], hi4[2], hi4[3]}, pb[kb], oacc[mb], 0, 0, 0);
                    }
                }
            }
#undef DSA_G
            bf16_t* op = (bf16_t*)(F.ws + WS_OLAT) + ((size_t)row * NH + head) * DLAT + half * 256 + 4 * g;
#pragma unroll
            for (int mb = 0; mb < 16; ++mb) { u32x2 w; w.x = cvt_pk_bf16(oacc[mb][0], oacc[mb][1]); w.y = cvt_pk_bf16(oacc[mb][2], oacc[mb][3]); *(u32x2*)(op + 16 * mb) = w; }
        }
    }
}

constexpr int NPHASE = 16;
struct Args { const float* in[22]; float* out; unsigned char* ws; int ph_lo, ph_hi; };
template <int OFF> __device__ __forceinline__ const float* karg_ptr() { unsigned long long v; asm volatile("s_load_dwordx2 %0, %1, %2\n\ts_waitcnt lgkmcnt(0)" : "=s"(v) : "s"(__builtin_amdgcn_kernarg_segment_ptr()), "n"(OFF) : "memory");
    return (const float*)(GAS const float*)v; }
template <int OFF> __device__ __forceinline__ int karg_int() { int v; asm volatile("s_load_dword %0, %1, %2\n\ts_waitcnt lgkmcnt(0)" : "=s"(v) : "s"(__builtin_amdgcn_kernarg_segment_ptr()), "n"(OFF) : "memory"); return v; }
#define ARGIN(k) karg_ptr<8 * (k)>()
__global__ void __launch_bounds__(NWAVES * 64, 2) mk_fwd(Args args) {
    extern __shared__ __attribute__((aligned(16))) unsigned char lds_raw[];
    Frame F;
    F.lds = (LAS unsigned char*)lds_raw;
    F.wave = __builtin_amdgcn_readfirstlane((int)threadIdx.x >> 6);
    F.G = gridDim.x; { const int bx = blockIdx.x; F.vcu = (F.G % 8 == 0) ? (bx % 8) * (F.G / 8) + bx / 8 : bx; }
    unsigned char* ws = (unsigned char*)karg_ptr<184>(); F.ws = ws;
    volatile LAS unsigned* MISC = (volatile LAS unsigned*)(F.lds + MISC_OFF);
    for (int u = (int)threadIdx.x; u < (LDS_BYTES - LDSCTL_OFF) / 4; u += NWAVES * 64) ((LAS unsigned*)(F.lds + LDSCTL_OFF))[u] = 0u;
    __syncthreads();
#if MK_SINGLE
    XcdBarrier bar = xcd_barrier_post((unsigned*)(ws + WS_CTL) + CW_BAR, MISC + 8, threadIdx.x == 0);
#define GRID_BAR() xcd_barrier(bar, F.wave == 0 && lane_id_v() == 0)
#else
    (void)MISC;
#define GRID_BAR() do {} while (0)
#endif
    const int lo = karg_int<192>(), hi = karg_int<196>();
#define IN(k) (lo <= (k) && (k) < hi)
#define BOTH(k) (IN(k) && IN((k) + 1))

    const float* x = ARGIN(0);
    bf16_t* XB = (bf16_t*)(ws + WS_XB); bf16_t* HID = (bf16_t*)(ws + WS_HID); bf16_t* H1B = (bf16_t*)(ws + WS_H1B); bf16_t* ATT = (bf16_t*)(ws + WS_ATT);
    bf16_t* PRE = (bf16_t*)(ws + WS_PRE);
    bf16_t* W1 = (bf16_t*)(ws + WS_W1); bf16_t* WD = (bf16_t*)(ws + WS_WD); bf16_t* WOUT = (bf16_t*)(ws + WS_WOUT);

    if (IN(0)) {
        convert_ffn(F, ARGIN(1), ARGIN(2), ARGIN(3));
        convert_x(F, x);
        if (BOTH(0)) GRID_BAR();
    }
    if (IN(1)) {
        pg8::Gemm g{XB, W1, DM, DM, DM}; pg8::StaticOrder S; S.init(M, 2 * DFF, F.G, (int)blockIdx.x);
        pg8::EpiSwiglu E{HID, DFF};
        pg8::gemm_phase<pg8::EpiSwiglu, pg8::StaticOrder, true>(F.lds, F.wave, g, S, E);
        {
            const int rem = S.nwg % F.G, c = (int)blockIdx.x;
            if (rem == 0) convert_misc(F, c, F.G, ARGIN(6), ARGIN(14), ARGIN(11), ARGIN(12));
            else if (c >= rem) convert_misc(F, c - rem, F.G - rem, ARGIN(6), ARGIN(14), ARGIN(11), ARGIN(12));
        }
        if (BOTH(1)) GRID_BAR();
    }
    if (IN(2)) {
        pg8::Gemm g{HID, WD, DFF, DFF, DFF}; pg8::StaticOrder S; S.init(M, DM, F.G, (int)blockIdx.x, 2);
        pg8::EpiResBf16<false> E{PRE, DM, x, DM, ALPHA, 0.5f};
        pg8::gemm_phase<pg8::EpiResBf16<false>, pg8::StaticOrder, true>(F.lds, F.wave, g, S, E);
        if (BOTH(2)) GRID_BAR();
    }
    if (IN(3)) { ln_phase<false>(F, PRE, ARGIN(4), ARGIN(5), H1B); if (BOTH(3)) GRID_BAR(); }
    bf16_t* PROJ = (bf16_t*)(ws + WS_PROJ); bf16_t* QLAT = (bf16_t*)(ws + WS_QLAT);
    if (IN(4)) {
        pg8::Gemm g{H1B, (const bf16_t*)(ws + WS_WIN), DM, DM, DM}; pg8::StaticOrder S; S.init(M, DINP, F.G, (int)blockIdx.x);
        pg8::EpiProj E{PROJ, (float*)(ws + WS_CKVRAW), (float*)(ws + WS_SMALL)};
        pg8::gemm_phase<pg8::EpiProj, pg8::StaticOrder, true>(F.lds, F.wave, g, S, E);
        if (BOTH(4)) GRID_BAR();
    }
    if (IN(5)) {
        p5_norms(F, ARGIN(8), ARGIN(9), ARGIN(10), ARGIN(7));
        __syncthreads();
        pg8::Gemm g{PROJ + PC_QA, (const bf16_t*)(ws + WS_WUK), PROJW, 256, 256}; pg8::QlatOrder S; S.init(M, NH * DLAT, F.G, (int)blockIdx.x);
        pg8::EpiBf16<false> E{QLAT, NH * DLAT};
        pg8::gemm_phase<pg8::EpiBf16<false>, pg8::QlatOrder, true>(F.lds, F.wave, g, S, E);
        if (BOTH(5)) GRID_BAR();
    }
    if (IN(6)) { __syncthreads(); indexer_phase(F); if (BOTH(6)) GRID_BAR(); }
    if (IN(7)) { topk_phase(F); if (BOTH(7)) GRID_BAR(); }
    if (IN(8)) { __syncthreads(); dsa_phase(F, ARGIN(13)); if (BOTH(8)) GRID_BAR(); }
    if (IN(9)) {
        pg8::Gemm g{(const bf16_t*)(ws + WS_OLAT), (const bf16_t*)(ws + WS_WUV), NH * DLAT, DLAT, DLAT}; pg8::OaOrder S; S.init(M, NH * 256, F.G, (int)blockIdx.x);
        pg8::EpiBf16<true> E{ATT, DM};
        pg8::gemm_phase<pg8::EpiBf16<true>, pg8::OaOrder, true>(F.lds, F.wave, g, S, E);
    }
    if (IN(10)) { __syncthreads(); fox_phase(F, (char*)lds_raw); if (BOTH(10)) GRID_BAR(); }
    if (IN(11)) {
        convert_ffn(F, ARGIN(17), ARGIN(18), ARGIN(19)); __syncthreads();
        pg8::Gemm g{ATT, WOUT, DM, DM, DM}; pg8::StaticOrder S; S.init(M, DM, F.G, (int)blockIdx.x);
        pg8::EpiResBf16<true> E{PRE, DM, H1B, DM, ALPHA, 1.0f};
        pg8::gemm_phase<pg8::EpiResBf16<true>, pg8::StaticOrder, true>(F.lds, F.wave, g, S, E);
        if (BOTH(11)) GRID_BAR();
    }
    if (IN(12)) { ln_phase<false>(F, PRE, ARGIN(15), ARGIN(16), H1B); if (BOTH(12)) GRID_BAR(); }
    if (IN(13)) {
        pg8::Gemm g{H1B, W1, DM, DM, DM}; pg8::StaticOrder S; S.init(M, 2 * DFF, F.G, (int)blockIdx.x);
        pg8::EpiSwiglu E{HID, DFF};
        pg8::gemm_phase<pg8::EpiSwiglu, pg8::StaticOrder, true>(F.lds, F.wave, g, S, E);
        if (BOTH(13)) GRID_BAR();
    }
    if (IN(14)) {
        pg8::Gemm g{HID, WD, DFF, DFF, DFF}; pg8::StaticOrder S; S.init(M, DM, F.G, (int)blockIdx.x, 2);
        pg8::EpiResBf16<true> E{PRE, DM, H1B, DM, ALPHA, 0.5f};
        pg8::gemm_phase<pg8::EpiResBf16<true>, pg8::StaticOrder, true>(F.lds, F.wave, g, S, E);
        if (BOTH(14)) GRID_BAR();
    }
    if (IN(15)) { ln_phase<true>(F, PRE, ARGIN(20), ARGIN(21), (float*)karg_ptr<176>()); }
#undef IN
#undef BOTH
}

extern "C" void kernel_launch(void* const* d_in, const int* in_sizes, int n_in, void* d_out, int out_size, void* d_ws, size_t ws_size, hipStream_t stream) {
    static int grid = 0;
    if (grid == 0) {
        if (n_in != 22 || in_sizes[0] != M * DM || out_size != M * DM || ws_size < WS_END) {
            fprintf(stderr, "kernel_launch: unexpected shapes: n_in %d in0 %d out %d ws %zu (need %zu)\n", n_in, n_in > 0 ? in_sizes[0] : -1, out_size, ws_size, (size_t)WS_END); grid = -1; return; }
        int dev = 0, cus = 0;
        if (hipGetDevice(&dev) != hipSuccess || hipDeviceGetAttribute(&cus, hipDeviceAttributeMultiprocessorCount, dev) != hipSuccess) { grid = -1; return; }
        if (hipFuncSetAttribute((const void*)mk_fwd, hipFuncAttributeMaxDynamicSharedMemorySize, LDS_BYTES) != hipSuccess) { fprintf(stderr, "kernel_launch: hipFuncSetAttribute failed\n"); grid = -1; return; }
        int per_cu = 0;
        if (hipOccupancyMaxActiveBlocksPerMultiprocessor(&per_cu, (const void*)mk_fwd, NWAVES * 64, LDS_BYTES) != hipSuccess || per_cu < 1) { fprintf(stderr, "kernel_launch: occupancy query says %d\n", per_cu); }
        (void)hipGetLastError();
        grid = cus;
    }
    if (grid < 0) return;
    (void)hipMemsetAsync((char*)d_ws + WS_CTL, 0, CTL_ZERO_BYTES, stream);
    Args a{};
    for (int i = 0; i < 22; ++i) a.in[i] = (const float*)d_in[i];
    a.out = (float*)d_out; a.ws = (unsigned char*)d_ws;
#if MK_SINGLE
    a.ph_lo = 0; a.ph_hi = NPHASE;
    hipLaunchKernelGGL(mk_fwd, dim3(grid), dim3(NWAVES * 64), LDS_BYTES, stream, a);
#else
    for (int p = 0; p < NPHASE; ++p) {
        a.ph_lo = p; a.ph_hi = p + 1;
        hipLaunchKernelGGL(mk_fwd, dim3(grid), dim3(NWAVES * 64), LDS_BYTES, stream, a);
    }
#endif
}
```

```cpp
#include <hip/hip_runtime.h>
#include <cstdio>
#include <cstdint>

#ifndef MK_SINGLE
#define MK_SINGLE 1
#endif

#define GAS __attribute__((address_space(1)))
#define LAS __attribute__((address_space(3)))
typedef unsigned short bf16_t;
typedef short bf16x8 __attribute__((ext_vector_type(8)));
typedef short s16x4 __attribute__((ext_vector_type(4)));
typedef float f32x4 __attribute__((ext_vector_type(4)));
typedef float f32x2 __attribute__((ext_vector_type(2)));
typedef float f32x16 __attribute__((ext_vector_type(16)));
typedef unsigned u32x4 __attribute__((ext_vector_type(4)));
typedef unsigned u32x2 __attribute__((ext_vector_type(2)));
typedef int i32x4 __attribute__((ext_vector_type(4)));

constexpr int NB = 4, SEQ = 4096, M = NB * SEQ, DM = 4096, DFF = 11008;
constexpr int NH = 16, HD = 128, DLAT = 512, NIH = 32, IDIM = 128, TOPK = 256, CHUNK = 64;
constexpr int DIN = 12976, DINP = 13056, PROJW = 12800;
constexpr int PC_QA = 0, PC_QI = 2560, PC_QB = 6656, PC_KB = 8704, PC_VB = 10752;
constexpr int SM_KI = 0, SM_WI = 128, SM_FB = 160;
constexpr float ALPHA = 1.189207115002721f;
constexpr float LN_EPS = 1e-5f, RMS_EPS = 1e-6f;

constexpr size_t MiB = 1u << 20;
constexpr size_t WS_CTL = 0, CTL_ZERO_BYTES = 1 * MiB;
constexpr size_t WS_W1 = 1 * MiB;
constexpr size_t WS_WD = WS_W1 + 172 * MiB;
constexpr size_t WS_SCORES = WS_W1;
constexpr size_t WS_WIN = WS_WD + 86 * MiB;
constexpr size_t WS_WOUT = WS_WIN + 102 * MiB;
constexpr size_t WS_WUK = WS_WOUT + 32 * MiB;
constexpr size_t WS_WUV = WS_WUK + 4 * MiB;
constexpr size_t WS_XB = WS_WUV + 3 * MiB;
constexpr size_t WS_HID = WS_XB + 128 * MiB;
constexpr size_t WS_PROJ = WS_XB;
constexpr size_t WS_PRE = WS_HID + 344 * MiB;
constexpr size_t WS_QLAT = WS_PRE;
constexpr size_t WS_OLAT = WS_W1;
constexpr size_t WS_H1B = WS_PRE + 256 * MiB;
constexpr size_t WS_ATT = WS_H1B + 128 * MiB;
constexpr size_t WS_SMALL = WS_ATT + 128 * MiB;
constexpr size_t WS_CKVRAW = WS_SMALL + 16 * MiB;
constexpr size_t WS_CKV = WS_CKVRAW + 32 * MiB;
constexpr size_t WS_KI = WS_CKV + 16 * MiB;
constexpr size_t WS_IDX = WS_KI + 4 * MiB;
constexpr size_t WS_CUMK = WS_IDX + 16 * MiB;
constexpr size_t WS_END = WS_CUMK + 1 * MiB;
static_assert(WS_END <= (size_t)1562 * MiB, "workspace map exceeds the guaranteed size");
static_assert((size_t)22016 * 4096 * 2 <= 172 * MiB && (size_t)4096 * 11008 * 2 <= 86 * MiB && (size_t)DINP * 4096 * 2 <= 102 * MiB, "weights");
static_assert((size_t)M * PROJW * 2 <= 472 * MiB && (size_t)M * 4096 * 4 <= 258 * MiB, "overlays");

constexpr int CW_BAR = 4096;

constexpr int RING_BYTES = 131072;
constexpr int LDSCTL_OFF = 143360, MISC_OFF = LDSCTL_OFF + 320;
constexpr int LDS_BYTES = 147456;
constexpr int NWAVES = 8;

#define LDS_WAIT() asm volatile("s_waitcnt lgkmcnt(0)" ::: "memory")
#define VM_WAIT() asm volatile("s_waitcnt vmcnt(0)" ::: "memory")

__device__ __forceinline__ unsigned cvt_pk_bf16(float lo, float hi) { unsigned r; asm volatile("v_cvt_pk_bf16_f32 %0, %1, %2" : "=v"(r) : "v"(lo), "v"(hi)); return r; }
__device__ __forceinline__ float bf2f(unsigned short b) { return __builtin_bit_cast(float, (unsigned)b << 16); }
__device__ __forceinline__ float bflo(unsigned w) { return __builtin_bit_cast(float, w << 16); }
__device__ __forceinline__ float bfhi(unsigned w) { return __builtin_bit_cast(float, w & 0xffff0000u); }

#define XB_TMO      128
#define XB_XCNT(j)  (256  + 64 * (j))
#define XB_XSUB(j)  (1280 + 64 * (j))
#define XB_XGEN(j)  (2304 + 64 * (j))
#define XB_TOP      3328
#define XB_TOPGEN   3392
#define XCD_BAR_WORDS 3456
#define XB_SPIN_CAP (1u << 23)
__device__ __forceinline__ unsigned xb_ld(unsigned* p)              { return __hip_atomic_load(p, __ATOMIC_RELAXED, __HIP_MEMORY_SCOPE_AGENT); }
__device__ __forceinline__ unsigned xb_add(unsigned* p, unsigned v) { return __hip_atomic_fetch_add(p, v, __ATOMIC_RELAXED, __HIP_MEMORY_SCOPE_AGENT); }
__device__ __forceinline__ unsigned xb_xcc_id() { return (unsigned)__builtin_amdgcn_s_getreg((3 << 11) | 20) & 0xFu; }
#define XB_SPIN(cond, bar) do { unsigned _sp = 0; while (cond) { __builtin_amdgcn_s_sleep(1); \
    if ((++_sp & 255u) == 0u) { if (xb_ld(&(bar)[XB_TMO])) break; if (_sp > XB_SPIN_CAP) { atomicAdd(&(bar)[XB_TMO], 1u); break; } } } } while (0)
struct XcdBarrier { unsigned* bar; unsigned x; volatile LAS unsigned* st; };
__device__ __forceinline__ XcdBarrier xcd_barrier_post(unsigned* bar, volatile LAS unsigned* st, bool t0) {
    XcdBarrier b; b.bar = bar; b.x = xb_xcc_id(); b.st = st;
    if (t0) (void)xb_add(&bar[XB_XCNT(b.x)], 1u);
    return b;
}
__device__ __forceinline__ void xcd_barrier_complete(unsigned* bar, unsigned x, unsigned& nloc, unsigned& nx) {
    const unsigned G = gridDim.x * gridDim.y * gridDim.z;
    unsigned sum, cnt, mine, sp = 0u;
    for (;;) {
        sum = 0u; cnt = 0u; mine = 0u;
#pragma unroll
        for (unsigned j = 0; j < 16; ++j) { const unsigned c = xb_ld(&bar[XB_XCNT(j)]); sum += c; cnt += (c > 0u) ? 1u : 0u; mine = (j == x) ? c : mine; }
        if (sum == G) break;
        __builtin_amdgcn_s_sleep(1);
        if ((++sp & 255u) == 0u) { if (xb_ld(&bar[XB_TMO])) break; if (sp > XB_SPIN_CAP) { atomicAdd(&bar[XB_TMO], 1u); break; } }
    }
    nloc = mine > 0u ? mine : 1u; nx = cnt > 0u ? cnt : 1u;
}
__device__ __forceinline__ void xcd_barrier(const XcdBarrier& b, bool t0) {
    asm volatile("s_waitcnt vmcnt(0)" ::: "memory");
    __syncthreads();
    if (t0) {
        unsigned* bar = b.bar;
        __builtin_amdgcn_s_waitcnt(0);
        unsigned nloc = b.st[0], nx = b.st[1];
        if (nloc == 0u) { xcd_barrier_complete(bar, b.x, nloc, nx); b.st[0] = nloc; b.st[1] = nx; }
        const unsigned old = xb_add(&bar[XB_XSUB(b.x)], 1u);
        const unsigned gen = old / nloc;
        if (old + 1u == (gen + 1u) * nloc) {
            __builtin_amdgcn_fence(__ATOMIC_RELEASE, "agent");
            asm volatile("s_waitcnt vmcnt(0)" ::: "memory");
            const unsigned og = xb_add(&bar[XB_TOP], 1u);
            const unsigned tg = og / nx;
            if (og + 1u == (tg + 1u) * nx) xb_add(&bar[XB_TOPGEN], 1u);
            else XB_SPIN(xb_ld(&bar[XB_TOPGEN]) == tg, bar);
            __builtin_amdgcn_fence(__ATOMIC_ACQUIRE, "agent");
            xb_add(&bar[XB_XGEN(b.x)], 1u);
            asm volatile("s_waitcnt vmcnt(0)" ::: "memory");
        } else {
            XB_SPIN(xb_ld(&bar[XB_XGEN(b.x)]) == gen, bar);
            __builtin_amdgcn_fence(__ATOMIC_ACQUIRE, "agent");
            asm volatile("s_waitcnt vmcnt(0)" ::: "memory");
        }
    }
    __syncthreads();
}

namespace pg8 {
constexpr int BM = 256, BK = 64, HALF = 128, HTB = HALF * BK * 2, NXCD = 8, WGM = 8;
__host__ __device__ __forceinline__ int lds_byte(int r, int c) { const int st = (r >> 4) * 2 + (c >> 5), rr = r & 15, cc = c & 31, ob = rr * 64 + cc * 2; return st * 1024 + (ob ^ (((ob >> 9) & 1) << 5)); }
__host__ __device__ __forceinline__ void stage_rc(int b, int& R, int& C) { const int st = b / 1024, sb = b % 1024, swz = sb ^ (((sb >> 9) & 1) << 5); R = (st >> 1) * 16 + swz / 64; C = (st & 1) * 32 + (swz % 64) / 2; }
__host__ __device__ __forceinline__ int perm32(int rho) { const int n = rho >> 4, i = rho & 15; return 8 * (i >> 2) + 4 * n + (i & 3); }

struct Unit { int pm, pn, aoff, boff; };
struct Gemm { const bf16_t* A; const bf16_t* Bt; int lda, ldb, K; };

struct StaticOrder {
    int nM, nN, nwg, G, c, wgm;
    __host__ __device__ void init(int M_, int N_, int G_, int c_, int wgm_ = WGM) { nM = M_ / BM; nN = N_ / BM; nwg = nM * nN; G = G_; c = c_; wgm = wgm_; }
    __host__ __device__ bool next(int i, Unit& u) const {
        const long L = (long)i * G + c; if (L >= nwg) return false;
        int wgid = (int)L; { const int q = nwg / NXCD, r = nwg % NXCD, xcd = wgid % NXCD, off = wgid / NXCD; wgid = (xcd < r ? xcd * (q + 1) : r * (q + 1) + (xcd - r) * q) + off; }
        const int nig = wgm * nN, gid = wgid / nig, fm = gid * wgm, gsz = (nM - fm) < wgm ? (nM - fm) : wgm;
        u.pm = fm + ((wgid % nig) % gsz); u.pn = (wgid % nig) / gsz; u.aoff = 0; u.boff = 0; return true;
    }
};
struct QlatOrder : StaticOrder {
    __host__ __device__ bool next(int i, Unit& u) const { if (!StaticOrder::next(i, u)) return false; u.aoff = (u.pn >> 1) * 128; return true; }
};
struct OaOrder : StaticOrder {
    __host__ __device__ bool next(int i, Unit& u) const { if (!StaticOrder::next(i, u)) return false; u.aoff = u.pn * 512; u.boff = -(u.pn * 128) * 512; return true; }
};

__device__ __forceinline__ float silu_f(float x) { return x * __builtin_amdgcn_rcpf(1.0f + __builtin_amdgcn_exp2f(-1.4426950408889634f * x)); }

struct EpiSwiglu {
    static constexpr bool PERM = true;
    bf16_t* O; int ldc;
    __device__ __forceinline__ void operator()(const f32x4 (&acc)[2][2][4][2], const Unit& u, int wr, int wc, int fr, int fq) const {
        const int row0 = u.pm * BM + wr * 64 + fr, col0 = u.pn * HALF + wc * 32 + 8 * fq;
#pragma unroll
        for (int ai = 0; ai < 2; ++ai)
#pragma unroll
            for (int m = 0; m < 4; ++m) {
                const f32x4 g0 = acc[ai][0][m][0], g1 = acc[ai][0][m][1], u0 = acc[ai][1][m][0], u1 = acc[ai][1][m][1];
                u32x4 w;
                w.x = cvt_pk_bf16(silu_f(g0[0]) * u0[0], silu_f(g0[1]) * u0[1]); w.y = cvt_pk_bf16(silu_f(g0[2]) * u0[2], silu_f(g0[3]) * u0[3]);
                w.z = cvt_pk_bf16(silu_f(g1[0]) * u1[0], silu_f(g1[1]) * u1[1]); w.w = cvt_pk_bf16(silu_f(g1[2]) * u1[2], silu_f(g1[3]) * u1[3]);
                *(u32x4*)(O + (size_t)(row0 + ai * HALF + m * 16) * ldc + col0) = w;
            }
    }
};
template <bool RES_BF16> struct EpiResBf16 {
    static constexpr bool PERM = true;
    bf16_t* C; int ldc; const void* res; int ldr; float ra, rb;
    __device__ __forceinline__ void operator()(const f32x4 (&acc)[2][2][4][2], const Unit& u, int wr, int wc, int fr, int fq) const {
        const int row0 = u.pm * BM + wr * 64 + fr, col0 = u.pn * BM + wc * 32 + 8 * fq;
#pragma unroll
        for (int ai = 0; ai < 2; ++ai)
#pragma unroll
            for (int m = 0; m < 4; ++m) {
                const size_t r = (size_t)(row0 + ai * HALF + m * 16);
#pragma unroll
                for (int bj = 0; bj < 2; ++bj) {
                    const int c = col0 + bj * HALF;
                    f32x4 r0, r1;
                    if constexpr (RES_BF16) { const u32x4 w = *(const u32x4*)((const bf16_t*)res + r * ldr + c); r0 = (f32x4){bflo(w.x), bfhi(w.x), bflo(w.y), bfhi(w.y)}; r1 = (f32x4){bflo(w.z), bfhi(w.z), bflo(w.w), bfhi(w.w)}; }
                    else { r0 = *(const f32x4*)((const float*)res + r * ldr + c); r1 = *(const f32x4*)((const float*)res + r * ldr + c + 4); }
                    const f32x4 v0 = r0 * ra + acc[ai][bj][m][0] * rb, v1 = r1 * ra + acc[ai][bj][m][1] * rb;
                    u32x4 o; o.x = cvt_pk_bf16(v0[0], v0[1]); o.y = cvt_pk_bf16(v0[2], v0[3]); o.z = cvt_pk_bf16(v1[0], v1[1]); o.w = cvt_pk_bf16(v1[2], v1[3]);
                    *(u32x4*)(C + r * ldc + c) = o;
                }
            }
    }
};
struct EpiProj {
    static constexpr bool PERM = true;
    bf16_t* P; float* ckvraw; float* small_;
    __device__ __forceinline__ void operator()(const f32x4 (&acc)[2][2][4][2], const Unit& u, int wr, int wc, int fr, int fq) const {
        const int row0 = u.pm * BM + wr * 64 + fr, cl = wc * 32 + 8 * fq;
        float* fdst = nullptr; int fld = 0;
        if (u.pn == 8 || u.pn == 9) { fdst = ckvraw + (u.pn - 8) * 256; fld = DLAT; }
        else if (u.pn == 50) { fdst = small_; fld = 256; }
#pragma unroll
        for (int ai = 0; ai < 2; ++ai)
#pragma unroll
            for (int m = 0; m < 4; ++m) {
                const size_t r = (size_t)(row0 + ai * HALF + m * 16);
#pragma unroll
                for (int bj = 0; bj < 2; ++bj) {
                    const f32x4 v0 = acc[ai][bj][m][0], v1 = acc[ai][bj][m][1];
                    if (fdst) { float* p = fdst + r * fld + cl + bj * HALF; *(f32x4*)p = v0; *(f32x4*)(p + 4) = v1; }
                    else { u32x4 w; w.x = cvt_pk_bf16(v0[0], v0[1]); w.y = cvt_pk_bf16(v0[2], v0[3]); w.z = cvt_pk_bf16(v1[0], v1[1]); w.w = cvt_pk_bf16(v1[2], v1[3]);
                           *(u32x4*)(P + r * PROJW + u.pn * BM + cl + bj * HALF) = w; }
                }
            }
    }
};
template <bool HALF_ONLY> struct EpiBf16 {
    static constexpr bool PERM = true;
    bf16_t* O; int ldc;
    __device__ __forceinline__ void operator()(const f32x4 (&acc)[2][2][4][2], const Unit& u, int wr, int wc, int fr, int fq) const {
        const int row0 = u.pm * BM + wr * 64 + fr, col0 = u.pn * (HALF_ONLY ? HALF : BM) + wc * 32 + 8 * fq;
#pragma unroll
        for (int ai = 0; ai < 2; ++ai)
#pragma unroll
            for (int m = 0; m < 4; ++m) {
                bf16_t* rowp = O + (size_t)(row0 + ai * HALF + m * 16) * ldc + col0;
#pragma unroll
                for (int bj = 0; bj < (HALF_ONLY ? 1 : 2); ++bj) {
                    const f32x4 v0 = acc[ai][bj][m][0], v1 = acc[ai][bj][m][1];
                    u32x4 w; w.x = cvt_pk_bf16(v0[0], v0[1]); w.y = cvt_pk_bf16(v0[2], v0[3]); w.z = cvt_pk_bf16(v1[0], v1[1]); w.w = cvt_pk_bf16(v1[2], v1[3]);
                    *(u32x4*)(rowp + bj * HALF) = w;
                }
            }
    }
};

template <class Epi, class Sched, bool ALIGN_EPI>
__device__ __forceinline__ void gemm_phase(LAS unsigned char* lds, int wid, const Gemm g, const Sched& S, const Epi& E) {
    int lane_; asm volatile("v_mbcnt_lo_u32_b32 %0, -1, 0\n\tv_mbcnt_hi_u32_b32 %0, -1, %0" : "=v"(lane_));
    const int lane = lane_ & 63, tid = wid * 64 + lane, wr = wid >> 2, wc = wid & 3, fr = lane & 15, fq = lane >> 4;
    const int K = g.K, nt = K / BK;
    unsigned voffA[2], voffB[2];
#pragma unroll
    for (int i = 0; i < 2; ++i) { int R, C; stage_rc(tid * 16 + i * 8192, R, C); const int Rb = Epi::PERM ? ((R & ~31) + perm32(R & 31)) : R;
        voffA[i] = (unsigned)(R * g.lda + C) * 2u; voffB[i] = (unsigned)(Rb * g.ldb + C) * 2u; }
    const size_t kstep = (size_t)(BK * 2);
    const size_t hstepA = (size_t)HALF * g.lda * 2, hstepB = (size_t)HALF * g.ldb * 2;
    const unsigned ldsw = (unsigned)wid * 1024u;
    const int aoff = lds_byte(wr * 64 + fr, fq * 8), boff = lds_byte(wc * 32 + fr, fq * 8);
#define PG8_SA(b, h) (((b) * 2 + (h)) * HTB)
#define PG8_SB(b, h) ((4 + (b) * 2 + (h)) * HTB)
#define PG8_STAGE(bufoff, gbase, voff) do { _Pragma("unroll") for (int _i = 0; _i < 2; ++_i) \
        __builtin_amdgcn_global_load_lds((const unsigned*)((const char*)(gbase) + (voff)[_i]), (LAS unsigned*)(lds + (bufoff) + ldsw + _i * 8192), 16, 0, 0); } while (0)
#define PG8_LDA(dst, b, h) do { _Pragma("unroll") for (int m = 0; m < 4; ++m) _Pragma("unroll") for (int k = 0; k < 2; ++k) dst[m][k] = *(const LAS bf16x8*)(lds + PG8_SA(b, h) + aoff + m * 2048 + k * 1024); } while (0)
#define PG8_LDB(dst, b, h) do { _Pragma("unroll") for (int n = 0; n < 2; ++n) _Pragma("unroll") for (int k = 0; k < 2; ++k) dst[n][k] = *(const LAS bf16x8*)(lds + PG8_SB(b, h) + boff + n * 2048 + k * 1024); } while (0)
#define PG8_MMA(ai, bj, At, Bt) do { __builtin_amdgcn_s_setprio(1); _Pragma("unroll") for (int m = 0; m < 4; ++m) _Pragma("unroll") for (int n = 0; n < 2; ++n) _Pragma("unroll") for (int k = 0; k < 2; ++k) \
        acc[ai][bj][m][n] = __builtin_amdgcn_mfma_f32_16x16x32_bf16(Bt[n][k], At[m][k], acc[ai][bj][m][n], 0, 0, 0); __builtin_amdgcn_s_setprio(0); } while (0)
#define PG8_WAIT_V(n) asm volatile("s_waitcnt vmcnt(" #n ")" ::: "memory")
#define PG8_WAIT_L(n) asm volatile("s_waitcnt lgkmcnt(" #n ")" ::: "memory")
#define PG8_BAR __builtin_amdgcn_s_barrier()
#define PG8_SCHED __builtin_amdgcn_sched_barrier(0)
    Unit cur, nxt; int ui = 0;
    if (!S.next(0, cur)) return;
    f32x4 acc[2][2][4][2];
#pragma unroll
    for (int a = 0; a < 2; ++a)
#pragma unroll
        for (int b = 0; b < 2; ++b)
#pragma unroll
            for (int m = 0; m < 4; ++m)
#pragma unroll
                for (int n = 0; n < 2; ++n) acc[a][b][m][n] = (f32x4){0.f, 0.f, 0.f, 0.f};
    bf16x8 At[4][2], B0[2][2], B1[2][2];
    const char* cA = (const char*)g.A + ((size_t)cur.pm * BM * g.lda + cur.aoff) * 2; const char* cB = (const char*)g.Bt + ((long)cur.pn * BM * g.ldb + cur.boff) * 2;
    PG8_STAGE(PG8_SB(0, 0), cB, voffB); PG8_STAGE(PG8_SB(0, 1), cB + hstepB, voffB); PG8_STAGE(PG8_SA(0, 0), cA, voffA); PG8_STAGE(PG8_SA(0, 1), cA + hstepA, voffA);
    if (wr == 1) PG8_BAR;
    PG8_WAIT_V(2); PG8_BAR;
    PG8_STAGE(PG8_SB(1, 0), cB + kstep, voffB); PG8_STAGE(PG8_SA(1, 0), cA + kstep, voffA); PG8_STAGE(PG8_SB(1, 1), cB + hstepB + kstep, voffB);
    PG8_WAIT_V(6); PG8_BAR;
    for (;;) {
        const bool has_next = S.next(ui + 1, nxt);
        const char* nA = has_next ? (const char*)g.A + ((size_t)nxt.pm * BM * g.lda + nxt.aoff) * 2 : cA; const char* nB = has_next ? (const char*)g.Bt + ((long)nxt.pn * BM * g.ldb + nxt.boff) * 2 : cB;
        for (int t = 0; t < nt; t += 2) {
            const bool last = (t == nt - 2);
            const char* a1 = cA + (size_t)(t + 1) * kstep;
            const char* a2 = last ? nA : cA + (size_t)(t + 2) * kstep; const char* b2 = last ? nB : cB + (size_t)(t + 2) * kstep;
            const char* a3 = a2 + kstep; const char* b3 = b2 + kstep;
            PG8_LDB(B0, 0, 0); PG8_LDB(B1, 0, 1); PG8_SCHED; PG8_LDA(At, 0, 0); PG8_STAGE(PG8_SA(1, 1), a1 + hstepA, voffA);
            PG8_WAIT_V(8); PG8_WAIT_L(0); PG8_BAR; PG8_MMA(0, 0, At, B0); PG8_MMA(0, 1, At, B1); PG8_BAR; PG8_SCHED;
            PG8_LDA(At, 0, 1); PG8_STAGE(PG8_SB(0, 0), b2, voffB); PG8_STAGE(PG8_SB(0, 1), b2 + hstepB, voffB); PG8_STAGE(PG8_SA(0, 0), a2, voffA);
            PG8_WAIT_V(8); PG8_WAIT_L(0); PG8_BAR; PG8_MMA(1, 0, At, B0); PG8_MMA(1, 1, At, B1); PG8_BAR; PG8_SCHED;
            PG8_LDB(B0, 1, 0); PG8_LDB(B1, 1, 1); PG8_SCHED; PG8_LDA(At, 1, 0); PG8_STAGE(PG8_SA(0, 1), a2 + hstepA, voffA);
            PG8_WAIT_V(8); PG8_WAIT_L(0); PG8_BAR; PG8_MMA(0, 0, At, B0); PG8_MMA(0, 1, At, B1); PG8_BAR; PG8_SCHED;
            PG8_LDA(At, 1, 1); PG8_STAGE(PG8_SB(1, 0), b3, voffB); PG8_STAGE(PG8_SB(1, 1), b3 + hstepB, voffB); PG8_STAGE(PG8_SA(1, 0), a3, voffA);
            PG8_WAIT_V(8); PG8_WAIT_L(0); PG8_BAR; PG8_MMA(1, 0, At, B0); PG8_MMA(1, 1, At, B1); PG8_BAR; PG8_SCHED;
        }
        if constexpr (ALIGN_EPI) { if (wr == 0) PG8_BAR; }
        E(acc, cur, wr, wc, fr, fq);
        if (!has_next) break;
#pragma unroll
        for (int a = 0; a < 2; ++a)
#pragma unroll
            for (int b = 0; b < 2; ++b)
#pragma unroll
                for (int m = 0; m < 4; ++m)
#pragma unroll
                    for (int n = 0; n < 2; ++n) acc[a][b][m][n] = (f32x4){0.f, 0.f, 0.f, 0.f};
        cur = nxt; cA = nA; cB = nB; ++ui;
        if constexpr (ALIGN_EPI) { if (wr == 1) PG8_BAR; }
    }
    PG8_WAIT_V(0);
    if constexpr (!ALIGN_EPI) { if (wr == 0) PG8_BAR; }
    PG8_BAR;
#undef PG8_SA
#undef PG8_SB
#undef PG8_STAGE
#undef PG8_LDA
#undef PG8_LDB
#undef PG8_MMA
#undef PG8_WAIT_V
#undef PG8_WAIT_L
#undef PG8_BAR
#undef PG8_SCHED
}
}

namespace fox {
constexpr int NW = 8, QBLK = 32, KVBLK = 64, QB = NW * QBLK, D = 128;
constexpr int SHM_V = KVBLK * D * 2, SHM_K = KVBLK * D * 2;
constexpr int OFF_WS = 2 * SHM_V + 2 * SHM_K, OFF_BL = OFF_WS + NW * 64 * 4, LDS_BYTES = OFF_BL + 512;
constexpr float SCALE = 0.08838834764831845f, THR = 8.f;
constexpr int LDQ = PROJW, LDO = DM;
constexpr unsigned WINF = 0x7fffffffu;

#define KSWZ(row, colB) ((row) * 256 + ((colB) ^ (((row) & 7) << 4)))
#define SBAR() __builtin_amdgcn_sched_barrier(0)
__device__ __forceinline__ int v_st(int k, int c) { const int kk = (k & ~0xC) | ((k & 4) << 1) | ((k & 8) >> 1); return ((kk >> 3) * 4 + (c >> 5)) * 512 + ((kk & 7) * 32 + (c & 31)) * 2; }
__device__ __forceinline__ int v_rd_base(int lane) { return ((lane & 3) << 3) | (((lane >> 2) & 3) << 6) | (((lane >> 4) & 1) << 5) | (((lane >> 5) & 1) << 8); }
constexpr int v_rd_off(int d0, int ks, int half) { return d0 * 512 + ks * 4096 + half * 2048; }
__device__ __forceinline__ int crow(int r, int hi) { return (r & 3) + 8 * (r >> 2) + 4 * hi; }
__device__ __forceinline__ unsigned cvtpk(float lo, float hi) { unsigned r; asm volatile("v_cvt_pk_bf16_f32 %0, %1, %2" : "=v"(r) : "v"(lo), "v"(hi)); return r; }
__device__ __forceinline__ bf16x8 load8(const bf16_t* p) { return *reinterpret_cast<const bf16x8*>(p); }
__device__ __forceinline__ void mask_tile(f32x16& p0, f32x16& p1, int dq) {
    const float NEG = -__builtin_inff();
#pragma unroll
    for (int r = 0; r < 16; ++r) {
        const int c = (r & 3) + 8 * (r >> 2);
        if (dq - c < 0) p0[r] = NEG;
        if (dq - c - 32 < 0) p1[r] = NEG;
    }
}
__device__ __forceinline__ void partialSM(f32x16& p0, f32x16& p1, float& m_reg, float& mn, float& alpha) {
    float pmax = p0[0]; for (int r = 1; r < 16; ++r) pmax = fmaxf(pmax, p0[r]); for (int r = 0; r < 16; ++r) pmax = fmaxf(pmax, p1[r]);
    { auto rr = __builtin_amdgcn_permlane32_swap(__float_as_uint(pmax), __float_as_uint(pmax), false, false);
      pmax = fmaxf(__uint_as_float(rr[0]), __uint_as_float(rr[1])); }
    constexpr float C2 = 1.4426950408889634f * SCALE;
    if (__builtin_expect(__all((pmax - m_reg) * SCALE <= THR), 1)) { mn = m_reg; alpha = 1.f; }
    else { mn = fmaxf(m_reg, pmax); alpha = __builtin_amdgcn_exp2f((m_reg - mn) * C2); m_reg = mn; }
    const float mnL = -mn * C2;
    for (int r = 0; r < 16; ++r) p0[r] = fmaf(p0[r], C2, mnL); for (int r = 0; r < 16; ++r) p1[r] = fmaf(p1[r], C2, mnL);
    for (int r = 0; r < 16; ++r) p0[r] = __builtin_amdgcn_exp2f(p0[r]);
}
__device__ __forceinline__ void finishSM(f32x16& p0, f32x16& p1, float alpha, float& l_reg, bf16x8& pa0, bf16x8& pa1, bf16x8& pa2, bf16x8& pa3) {
    for (int r = 0; r < 16; ++r) p1[r] = __builtin_amdgcn_exp2f(p1[r]);
    float ps = 0; for (int r = 0; r < 16; ++r) ps += p0[r]; for (int r = 0; r < 16; ++r) ps += p1[r];
    { auto rr = __builtin_amdgcn_permlane32_swap(__float_as_uint(ps), __float_as_uint(ps), false, false);
      ps = __uint_as_float(rr[0]) + __uint_as_float(rr[1]); }
    l_reg = l_reg * alpha + ps;
#define PK4(P, B_, OUT) do { unsigned a0 = cvtpk(P[B_+0], P[B_+1]), a1 = cvtpk(P[B_+2], P[B_+3]);                          \
        unsigned b0 = cvtpk(P[B_+4], P[B_+5]), b1 = cvtpk(P[B_+6], P[B_+7]);                                             \
        auto r0 = __builtin_amdgcn_permlane32_swap(a0, b0, false, false); auto r1 = __builtin_amdgcn_permlane32_swap(a1, b1, false, false); \
        u32x4 w = {r0[0], r1[0], r0[1], r1[1]}; OUT = *reinterpret_cast<bf16x8*>(&w); } while (0)
    PK4(p0, 0, pa0); PK4(p0, 8, pa1); PK4(p1, 0, pa2); PK4(p1, 8, pa3);
#undef PK4
}
template <int KB>
__device__ __forceinline__ void qkt(f32x16& p0, f32x16& p1, const char* K_lds, const char* BL, int r32, int hi, const bf16x8* qr) {
    { const f32x4* bp = reinterpret_cast<const f32x4*>(BL + KB * 256 + hi * 16);
      const f32x4 a0 = bp[0], a1 = bp[2], a2 = bp[4], a3 = bp[6], c0 = bp[8], c1 = bp[10], c2 = bp[12], c3 = bp[14];
      p0 = (f32x16){a0[0], a0[1], a0[2], a0[3], a1[0], a1[1], a1[2], a1[3], a2[0], a2[1], a2[2], a2[3], a3[0], a3[1], a3[2], a3[3]};
      p1 = (f32x16){c0[0], c0[1], c0[2], c0[3], c1[0], c1[1], c1[2], c1[3], c2[0], c2[1], c2[2], c2[3], c3[0], c3[1], c3[2], c3[3]}; }
    const char* kb[4];
#pragma unroll
    for (int dd = 0; dd < 4; ++dd) kb[dd] = K_lds + KB * SHM_K + KSWZ(r32, (dd * 16 + hi * 8) * 2);
#pragma unroll
    for (int d0 = 0; d0 < 8; ++d0) { const char* a = kb[d0 & 3] + (d0 >> 2) * 128;
        bf16x8 b0 = *reinterpret_cast<const bf16x8*>(a);
        bf16x8 b1 = *reinterpret_cast<const bf16x8*>(a + 32 * 256);
        p0 = __builtin_amdgcn_mfma_f32_32x32x16_bf16(b0, qr[d0], p0, 0, 0, 0);
        p1 = __builtin_amdgcn_mfma_f32_32x32x16_bf16(b1, qr[d0], p1, 0, 0, 0); }
}
template <int VB>
__device__ __forceinline__ void pv_tile(f32x16* o, int vb0, bf16x8 pa0, bf16x8 pa1, bf16x8 pa2, bf16x8 pa3) {
#define TRRD(dst, off) asm volatile("ds_read_b64_tr_b16 %0, %1 offset:%2" : "=&v"(dst) : "v"(vb0), "i"(off) : "memory")
#define PV_D0(d0) do { s16x4 l0, l1, l2, l3, h0, h1, h2, h3; constexpr int b_ = VB * SHM_V + v_rd_off(d0, 0, 0); \
        TRRD(l0, b_); TRRD(h0, b_ + 2048); TRRD(l1, b_ + 4096); TRRD(h1, b_ + 6144); TRRD(l2, b_ + 8192); TRRD(h2, b_ + 10240); TRRD(l3, b_ + 12288); TRRD(h3, b_ + 14336); \
        asm volatile("s_waitcnt lgkmcnt(0)" ::: "memory"); SBAR();   \
        o[d0] = __builtin_amdgcn_mfma_f32_32x32x16_bf16(pa0, (bf16x8){l0[0], l0[1], l0[2], l0[3], h0[0], h0[1], h0[2], h0[3]}, o[d0], 0, 0, 0);   \
        o[d0] = __builtin_amdgcn_mfma_f32_32x32x16_bf16(pa1, (bf16x8){l1[0], l1[1], l1[2], l1[3], h1[0], h1[1], h1[2], h1[3]}, o[d0], 0, 0, 0);   \
        o[d0] = __builtin_amdgcn_mfma_f32_32x32x16_bf16(pa2, (bf16x8){l2[0], l2[1], l2[2], l2[3], h2[0], h2[1], h2[2], h2[3]}, o[d0], 0, 0, 0);   \
        o[d0] = __builtin_amdgcn_mfma_f32_32x32x16_bf16(pa3, (bf16x8){l3[0], l3[1], l3[2], l3[3], h3[0], h3[1], h3[2], h3[3]}, o[d0], 0, 0, 0); } while (0)
    PV_D0(0); PV_D0(1); PV_D0(2); PV_D0(3);
#undef PV_D0
#undef TRRD
}
struct BlockRef { unsigned qo, ko, vo, oo, bo; int P0; };
struct Rsrc { __amdgpu_buffer_rsrc_t proj, att, cum; };
__device__ __forceinline__ bf16x8 bload8(__amdgpu_buffer_rsrc_t r, unsigned voff, unsigned soff) { return __builtin_bit_cast(bf16x8, __builtin_amdgcn_raw_buffer_load_b128(r, voff, soff, 0)); }
struct Seam { bf16x8 qr[8]; bf16x8 st_v0, st_v1; };
#define VMW() asm volatile("s_waitcnt vmcnt(0)" ::: "memory")
#define VMWN(n) asm volatile("s_waitcnt vmcnt(%0)" :: "i"(n) : "memory")
#define SLOAD_H(R, k0, bf) do { const unsigned ks_ = (R).ko + (unsigned)(k0) * (LDQ * 2), vs_ = (R).vo + (unsigned)(k0) * (LDQ * 2); \
                         S.st_v0 = bload8(RS.proj, rowoff, vs_); S.st_v1 = bload8(RS.proj, rowoff, vs_ + 32 * LDQ * 2);              \
                         __builtin_amdgcn_raw_ptr_buffer_load_lds(RS.proj, (LAS void*)(ldsl + 2 * SHM_V + (bf) * SHM_K + wid * 2048), 16, koff0, ks_, 0, 0); \
                         __builtin_amdgcn_raw_ptr_buffer_load_lds(RS.proj, (LAS void*)(ldsl + 2 * SHM_V + (bf) * SHM_K + wid * 2048 + 1024), 16, koff1, ks_, 0, 0); \
                         if (wid == 0) __builtin_amdgcn_raw_ptr_buffer_load_lds(RS.cum, (LAS void*)(ldsl + OFF_BL + (bf) * 256), 4, (unsigned)lane * 4u, (R).bo + (unsigned)(k0) * 4u, 0, 0); } while (0)
#define KOFFS() const unsigned koff0 = (unsigned)((wid * 8 + (lane >> 4)) * LDQ + (((lane & 15) ^ ((lane >> 4) & 7)) * 8)) * 2u, \
                               koff1 = (unsigned)((wid * 8 + 4 + (lane >> 4)) * LDQ + (((lane & 15) ^ (((lane >> 4) + 4) & 7)) * 8)) * 2u
#define SWRITE_HV(bf) do { *(bf16x8*)(V_lds + (bf) * SHM_V + vst0) = S.st_v0; *(bf16x8*)(V_lds + (bf) * SHM_V + vst1) = S.st_v1; } while (0)
#define SWRITE_H(bf) SWRITE_HV(bf)
#define QLOAD(R) do { const unsigned qs_ = (R).qo + (unsigned)(wid * QBLK) * (LDQ * 2); _Pragma("unroll") for (int d0 = 0; d0 < 8; ++d0) S.qr[d0] = bload8(RS.proj, qoff + d0 * 32, qs_); } while (0)
__device__ __forceinline__ void fox_prime(const BlockRef& cur, const Rsrc& RS, char* lds, LAS unsigned char* ldsl, int wid, int lane, Seam& S) {
    const int tid = wid * 64 + lane, r32 = lane & 31, hi = lane >> 5;
    const unsigned rowoff = (unsigned)((tid >> 4) * LDQ + (tid & 15) * 8) * 2u, qoff = (unsigned)(r32 * LDQ + hi * 8) * 2u;
    KOFFS();
    QLOAD(cur);
    SLOAD_H(cur, 0, 0); VMW();
    __syncthreads();
}
__device__ __forceinline__ void fox_block(const BlockRef& cur, const BlockRef& nxt, const Rsrc& RS, char* lds, LAS unsigned char* ldsl, int wid, int lane, Seam& S) {
    const int tid = wid * 64 + lane, r32 = lane & 31, hi = lane >> 5;
    const int NT = (cur.P0 + QB - 1) / KVBLK + 1;
    const int qlo = cur.P0 + wid * QBLK;
    char* V_lds = lds; char* K_lds = lds + 2 * SHM_V; char* BL = lds + OFF_BL;
    float* ws = (float*)(lds + OFF_WS) + wid * 64; float* li_l = ws, * al_l = ws + 32;
    const unsigned rowoff = (unsigned)((tid >> 4) * LDQ + (tid & 15) * 8) * 2u, qoff = (unsigned)(r32 * LDQ + hi * 8) * 2u;
    float m_reg = -1e30f, l_reg = 0; f32x16 o[4] = {};
    const int sr = tid >> 4, sc = (tid & 15) * 8, vst0 = v_st(sr, sc), vst1 = v_st(32 + sr, sc);
    KOFFS();
    const int vb0 = (int)(uintptr_t)V_lds + v_rd_base(lane);
#define RESC(a) do { if (__any((a) < 1.f)) { int l_; asm volatile("v_mbcnt_lo_u32_b32 %0, -1, 0\n\tv_mbcnt_hi_u32_b32 %0, -1, %0" : "=v"(l_)); l_ &= 63; const int h_ = l_ >> 5; \
                     if (h_ == 0) al_l[l_ & 31] = (a); asm volatile("s_waitcnt lgkmcnt(0)" ::: "memory");              \
                     for (int d_ = 0; d_ < 4; ++d_) for (int r = 0; r < 16; ++r) o[d_][r] *= al_l[crow(r, h_)]; } } while (0)
#define KBASE(t) ((t) * KVBLK)
#define MASKT(P0_, P1_, t) do { const int kb_ = KBASE(t); if (kb_ + KVBLK - 1 > qlo) { int l_; asm volatile("v_mbcnt_lo_u32_b32 %0, -1, 0\n\tv_mbcnt_hi_u32_b32 %0, -1, %0" : "=v"(l_)); l_ &= 63; \
        mask_tile(P0_, P1_, qlo + (l_ & 31) - 4 * (l_ >> 5) - kb_); } } while (0)
    constexpr int NQL = 8;
#define SEAM_K0() do { VMWN(NQL); SBAR(); } while (0)
    f32x16 pA0, pA1, pB0, pB1; float mnA, mnB, alA, alB; bf16x8 pa0, pa1, pa2, pa3;
    SWRITE_HV(0); SBAR();
    if (NT > 1) { SLOAD_H(cur, KBASE(1), 1); }
    SBAR(); qkt<0>(pA0, pA1, K_lds, BL, r32, hi, S.qr);
    MASKT(pA0, pA1, 0); partialSM(pA0, pA1, m_reg, mnA, alA);
    if (NT > 1) { VMW(); SWRITE_H(1); }
    __syncthreads();
#define HALF_STEP(PX0, PX1, mnX, alX, PY0, PY1, alY, t, KB, VB, SB) do {                                                      \
        SBAR(); qkt<KB>(PX0, PX1, K_lds, BL, r32, hi, S.qr);                                             \
        finishSM(PY0, PY1, alY, l_reg, pa0, pa1, pa2, pa3); SBAR();                                                           \
        if ((t) + 1 < NT) { SLOAD_H(cur, KBASE((t) + 1), SB); SBAR(); }                                               \
        pv_tile<VB>(o, vb0, pa0, pa1, pa2, pa3); MASKT(PX0, PX1, (t)); partialSM(PX0, PX1, m_reg, mnX, alX);                                        \
        __syncthreads();                                                                                                      \
        if ((t) + 1 < NT) { VMW(); SWRITE_H(SB); }                                                                          \
        RESC(alX); __syncthreads(); } while (0)
    for (int t = 1; t + 1 < NT; t += 2) {
        HALF_STEP(pB0, pB1, mnB, alB, pA0, pA1, alA, t, 1, 0, 0);
        HALF_STEP(pA0, pA1, mnA, alA, pB0, pB1, alB, t + 1, 0, 1, 1);
    }
    const bool even = (NT & 1) == 0;
    if (even) { SBAR(); qkt<1>(pB0, pB1, K_lds, BL, r32, hi, S.qr); SBAR(); }
    SLOAD_H(nxt, 0, 0); SBAR();
    QLOAD(nxt);
    SBAR();
    finishSM(pA0, pA1, alA, l_reg, pa0, pa1, pa2, pa3); SBAR();
    pv_tile<0>(o, vb0, pa0, pa1, pa2, pa3);
    if (even) { MASKT(pB0, pB1, NT - 1); partialSM(pB0, pB1, m_reg, mnB, alB); __syncthreads(); RESC(alB);
        finishSM(pB0, pB1, alB, l_reg, pa0, pa1, pa2, pa3); SBAR(); pv_tile<1>(o, vb0, pa0, pa1, pa2, pa3); }
    SBAR(); SEAM_K0();
    if (hi == 0) li_l[r32] = l_reg; asm volatile("s_waitcnt lgkmcnt(0)" ::: "memory");
    float rli[16];
#pragma unroll
    for (int r = 0; r < 16; ++r) rli[r] = __builtin_amdgcn_rcpf(li_l[crow(r, hi)]);
    const unsigned os_ = cur.oo + (unsigned)(wid * QBLK) * (LDO * 2), ov_ = (unsigned)(4 * hi * LDO + r32) * 2u;
#pragma unroll
    for (int r = 0; r < 16; ++r) { const int orc = (r & 3) + 8 * (r >> 2);
#pragma unroll
        for (int d0 = 0; d0 < 4; ++d0) { const float v = o[d0][r] * rli[r];
            const float vn = __shfl_xor(v, 1);
            if ((r32 & 1) == 0) __builtin_amdgcn_raw_buffer_store_b32(cvtpk(v, vn), RS.att, ov_, os_ + (unsigned)(orc * LDO + d0 * 32) * 2u, 0); } }
    __syncthreads();
#undef RESC
#undef KBASE
#undef MASKT
#undef SEAM_K0
#undef HALF_STEP
}
#undef QLOAD
#undef VMW
#undef VMWN
#undef SLOAD_H
#undef KOFFS
#undef SWRITE_HV
#undef SWRITE_H
#undef KSWZ
#undef SBAR
}

struct Frame {
    LAS unsigned char* lds;
    int wave, vcu, G;
    unsigned char* ws;
};
__device__ __forceinline__ int lane_id_v() { int l; asm volatile("v_mbcnt_lo_u32_b32 %0, -1, 0\n\tv_mbcnt_hi_u32_b32 %0, -1, %0" : "=v"(l)); return l & 63; }
__device__ __forceinline__ float wave_sum(float v) {
#pragma unroll
    for (int o = 1; o < 64; o <<= 1) v += __shfl_xor(v, o);
    return v;
}

__device__ __forceinline__ void transpose_item(const float* W, int ldw, int k0, int n0, int nvalid, bf16_t* WT, int ldt, int drow0, LAS float* scr, int lane) {
    const int nn = (lane & 31) < nvalid ? (lane & 31) : (nvalid - 1);
#pragma unroll 8
    for (int i = 0; i < 32; ++i) { const int kk = 2 * i + (lane >> 5); scr[kk * 33 + (lane & 31)] = W[(size_t)(k0 + kk) * ldw + n0 + nn]; }
    LDS_WAIT(); asm volatile("" ::: "memory");
    const int c = lane & 7;
#pragma unroll
    for (int j = 0; j < 4; ++j) { const int n = (lane >> 3) + 8 * j; const LAS float* s = scr + (8 * c) * 33 + n;
        u32x4 o; o.x = cvt_pk_bf16(s[0 * 33], s[1 * 33]); o.y = cvt_pk_bf16(s[2 * 33], s[3 * 33]); o.z = cvt_pk_bf16(s[4 * 33], s[5 * 33]); o.w = cvt_pk_bf16(s[6 * 33], s[7 * 33]);
        if (n >= nvalid) o = (u32x4){0u, 0u, 0u, 0u};
        *(u32x4*)(WT + (size_t)(drow0 + n) * ldt + k0 + 8 * c) = o; }
    LDS_WAIT(); asm volatile("" ::: "memory");
}
__device__ __forceinline__ int win_row(int n0) {
    if (n0 < 6656) return n0;
    if (n0 < 6784) return 12800 + SM_KI + (n0 - 6656);
    if (n0 < 6816) return 12800 + SM_WI + (n0 - 6784);
    if (n0 < 12960) return 6656 + (n0 - 6816);
    return 12800 + SM_FB + (n0 - 12960);
}
__device__ __forceinline__ void convert_ffn(Frame& F, const float* wg, const float* wu, const float* wd) {
    const int lane = lane_id_v();
    LAS float* scr = (LAS float*)(F.lds + F.wave * 16384);
    bf16_t* W1 = (bf16_t*)(F.ws + WS_W1); bf16_t* WD = (bf16_t*)(F.ws + WS_WD);
    const int gw = F.vcu * NWAVES + F.wave, NGW = F.G * NWAVES;
    constexpr int I_G = (DM / 64) * (DFF / 32), I_D = (DFF / 64) * (DM / 32);
    for (int it = gw; it < 2 * I_G + I_D; it += NGW) {
        int r = it;
        if (r < 2 * I_G) { const int up = r >= I_G; if (up) r -= I_G; const int nblk = DFF / 32, kb = r / nblk, nb = r % nblk, n0 = nb * 32;
            transpose_item(up ? wu : wg, DFF, kb * 64, n0, 32, W1, DM, (n0 >> 7) * 256 + (n0 & 127) + (up ? 128 : 0), scr, lane); continue; }
        r -= 2 * I_G;
        { const int nblk = DM / 32, kb = r / nblk, nb = r % nblk; transpose_item(wd, DM, kb * 64, nb * 32, 32, WD, DFF, nb * 32, scr, lane); }
    }
}
__device__ __forceinline__ void convert_misc(Frame& F, const float* w_in, const float* w_out, const float* w_uk, const float* w_uv, const float* x) {
    const int lane = lane_id_v(), tid = F.wave * 64 + lane;
    LAS float* scr = (LAS float*)(F.lds + F.wave * 16384);
    bf16_t* WIN = (bf16_t*)(F.ws + WS_WIN); bf16_t* WOUT = (bf16_t*)(F.ws + WS_WOUT); bf16_t* WUK = (bf16_t*)(F.ws + WS_WUK); bf16_t* WUV = (bf16_t*)(F.ws + WS_WUV);
    const int gw = F.vcu * NWAVES + F.wave, NGW = F.G * NWAVES;
    constexpr int NBI = (DIN + 31) / 32;
    constexpr int I_IN = (DM / 64) * NBI, I_OUT = (DM / 64) * (DM / 32), I_UK = NH * (HD / 64) * (DLAT / 32), I_UV = NH * (DLAT / 64) * (HD / 32);
    for (int it = gw; it < I_IN + I_OUT + I_UK + I_UV; it += NGW) {
        int r = it;
        if (r < I_IN) { const int kb = r / NBI, nb = r % NBI, n0 = nb * 32; const int nv = (DIN - n0) < 32 ? (DIN - n0) : 32;
            transpose_item(w_in, DIN, kb * 64, n0, nv, WIN, DM, win_row(n0), scr, lane); continue; }
        r -= I_IN;
        if (r < I_OUT) { const int nblk = DM / 32, kb = r / nblk, nb = r % nblk; transpose_item(w_out, DM, kb * 64, nb * 32, 32, WOUT, DM, nb * 32, scr, lane); continue; }
        r -= I_OUT;
        if (r < I_UK) { const int per = (HD / 64) * (DLAT / 32), h = r / per, q = r % per, kb = q / (DLAT / 32), nb = q % (DLAT / 32);
            transpose_item(w_uk + (size_t)h * HD * DLAT, DLAT, kb * 64, nb * 32, 32, WUK, 256, h * DLAT + nb * 32, scr, lane); continue; }
        r -= I_UK;
        { const int per = (DLAT / 64) * (HD / 32), h = r / per, q = r % per, kb = q / (HD / 32), nb = q % (HD / 32);
            transpose_item(w_uv + (size_t)h * DLAT * HD, HD, kb * 64, nb * 32, 32, WUV, DLAT, h * HD + nb * 32, scr, lane); }
    }
    const int gt = F.vcu * (NWAVES * 64) + tid, NGT = F.G * NWAVES * 64;
    const u32x4 z = (u32x4){0u, 0u, 0u, 0u};
    for (int i = gt; i < (DINP - 12992) * (DM / 8); i += NGT) *(u32x4*)(WIN + (size_t)12992 * DM + (size_t)i * 8) = z;
    for (int i = gt; i < NH * DLAT * 16; i += NGT) { const int row = i >> 4, c = i & 15; *(u32x4*)(WUK + (size_t)row * 256 + 128 + c * 8) = z; }
    for (int i = gt; i < 128 * (DLAT / 8); i += NGT) *(u32x4*)(WUV + (size_t)2048 * DLAT + (size_t)i * 8) = z;
    bf16_t* XB = (bf16_t*)(F.ws + WS_XB);
    for (size_t i = gt; i < (size_t)M * DM / 8; i += NGT) { const f32x4 a = *(const f32x4*)(x + i * 8), b = *(const f32x4*)(x + i * 8 + 4);
        u32x4 w; w.x = cvt_pk_bf16(a[0], a[1]); w.y = cvt_pk_bf16(a[2], a[3]); w.z = cvt_pk_bf16(b[0], b[1]); w.w = cvt_pk_bf16(b[2], b[3]); *(u32x4*)(XB + i * 8) = w; }
}

template <bool OUT_F32>
__device__ __forceinline__ void ln_phase(Frame& F, const bf16_t* pre, const float* g, const float* b, void* out) {
    const int lane = lane_id_v();
    const int gw = F.vcu * NWAVES + F.wave, NGW = F.G * NWAVES;
    for (int m = gw; m < M; m += NGW) {
        const u32x4* xr = (const u32x4*)(pre + (size_t)m * DM) + lane;
        f32x4 v[16]; float s = 0.f;
#pragma unroll
        for (int j = 0; j < 8; ++j) { const u32x4 w = xr[64 * j]; v[2 * j] = (f32x4){bflo(w.x), bfhi(w.x), bflo(w.y), bfhi(w.y)}; v[2 * j + 1] = (f32x4){bflo(w.z), bfhi(w.z), bflo(w.w), bfhi(w.w)};
            s += ((v[2 * j].x + v[2 * j].y) + (v[2 * j].z + v[2 * j].w)) + ((v[2 * j + 1].x + v[2 * j + 1].y) + (v[2 * j + 1].z + v[2 * j + 1].w)); }
        const float mean = wave_sum(s) * (1.f / DM); float s2 = 0.f;
#pragma unroll
        for (int j = 0; j < 16; ++j) { v[j] = v[j] - mean; s2 += (v[j].x * v[j].x + v[j].y * v[j].y) + (v[j].z * v[j].z + v[j].w * v[j].w); }
        const float rstd = 1.f / __builtin_sqrtf(wave_sum(s2) * (1.f / DM) + LN_EPS);
#pragma unroll
        for (int j = 0; j < 8; ++j) {
            const f32x4 g0 = ((const f32x4*)g)[(64 * j + lane) * 2], g1 = ((const f32x4*)g)[(64 * j + lane) * 2 + 1], b0 = ((const f32x4*)b)[(64 * j + lane) * 2], b1 = ((const f32x4*)b)[(64 * j + lane) * 2 + 1];
            const f32x4 y0 = v[2 * j] * rstd * g0 + b0, y1 = v[2 * j + 1] * rstd * g1 + b1;
            if constexpr (OUT_F32) { f32x4* o = (f32x4*)((float*)out + (size_t)m * DM) + (64 * j + lane) * 2; o[0] = y0; o[1] = y1; }
            else { u32x4 w; w.x = cvt_pk_bf16(y0.x, y0.y); w.y = cvt_pk_bf16(y0.z, y0.w); w.z = cvt_pk_bf16(y1.x, y1.y); w.w = cvt_pk_bf16(y1.z, y1.w); ((u32x4*)((bf16_t*)out + (size_t)m * DM))[64 * j + lane] = w; }
        }
    }
}

__device__ __forceinline__ void p5_norms(Frame& F, const float* kv_g, const float* ik_g, const float* ik_b, const float* b_f) {
    const float* CKVRAW = (const float*)(F.ws + WS_CKVRAW); const float* SMALL = (const float*)(F.ws + WS_SMALL);
    bf16_t* CKV = (bf16_t*)(F.ws + WS_CKV); bf16_t* KI = (bf16_t*)(F.ws + WS_KI); float* CUMK = (float*)(F.ws + WS_CUMK);
    const int gw = F.vcu * NWAVES + F.wave, NGW = F.G * NWAVES, lane = lane_id_v();
    if (gw < NB * NH) {
        const int b = gw / NH, h = gw % NH; const float bf = b_f[h];
        const float* src = SMALL + (size_t)(b * SEQ + lane * 64) * 256 + SM_FB + h;
        double tot = 0.0;
        for (int i = 0; i < 64; ++i) { const float z = src[(size_t)i * 256] + bf; const float lf = fminf(z, 0.f) - log1pf(expf(-fabsf(z))); tot += (double)lf; }
        double incl = tot;
#pragma unroll
        for (int o = 1; o < 64; o <<= 1) { const double t = __shfl_up(incl, o); if (lane >= o) incl += t; }
        double run = incl - tot;
        float* dst = CUMK + (size_t)gw * SEQ + lane * 64;
        for (int i = 0; i < 64; ++i) { const float z = src[(size_t)i * 256] + bf; const float lf = fminf(z, 0.f) - log1pf(expf(-fabsf(z))); run += (double)lf;
            dst[i] = (float)(-run * 11.313708498984761); }
    }
    for (int m = gw; m < M; m += NGW) {
        {
            const f32x4 a = *(const f32x4*)(CKVRAW + (size_t)m * DLAT + lane * 8), c = *(const f32x4*)(CKVRAW + (size_t)m * DLAT + lane * 8 + 4);
            const float ss = wave_sum((a.x * a.x + a.y * a.y) + (a.z * a.z + a.w * a.w) + (c.x * c.x + c.y * c.y) + (c.z * c.z + c.w * c.w));
            const float r = 1.f / __builtin_sqrtf(ss * (1.f / DLAT) + RMS_EPS);
            const f32x4 g0 = *(const f32x4*)(kv_g + lane * 8), g1 = *(const f32x4*)(kv_g + lane * 8 + 4);
            u32x4 w; w.x = cvt_pk_bf16(a.x * r * g0.x, a.y * r * g0.y); w.y = cvt_pk_bf16(a.z * r * g0.z, a.w * r * g0.w);
            w.z = cvt_pk_bf16(c.x * r * g1.x, c.y * r * g1.y); w.w = cvt_pk_bf16(c.z * r * g1.z, c.w * r * g1.w);
            *(u32x4*)(CKV + (size_t)m * DLAT + lane * 8) = w;
        }
        {
            const f32x2 v = *(const f32x2*)(SMALL + (size_t)m * 256 + SM_KI + lane * 2);
            const float mean = wave_sum(v.x + v.y) * (1.f / IDIM); const float d0 = v.x - mean, d1 = v.y - mean;
            const float r = 1.f / __builtin_sqrtf(wave_sum(d0 * d0 + d1 * d1) * (1.f / IDIM) + LN_EPS);
            const f32x2 g = *(const f32x2*)(ik_g + lane * 2), bb = *(const f32x2*)(ik_b + lane * 2);
            *(unsigned*)(KI + (size_t)m * IDIM + lane * 2) = cvt_pk_bf16(d0 * r * g.x + bb.x, d1 * r * g.y + bb.y);
        }
    }
}

__device__ __forceinline__ fox::BlockRef fox_ref(int bh, int qb) {
    const int b = bh / NH, h = bh % NH; fox::BlockRef r;
    r.qo = (unsigned)(((size_t)(b * SEQ + qb * 256) * PROJW + PC_QB + h * HD) * 2);
    r.ko = (unsigned)(((size_t)(b * SEQ) * PROJW + PC_KB + h * HD) * 2); r.vo = (unsigned)(((size_t)(b * SEQ) * PROJW + PC_VB + h * HD) * 2);
    r.oo = (unsigned)(((size_t)(b * SEQ + qb * 256) * DM + 2048 + h * HD) * 2); r.bo = (unsigned)(bh * SEQ * 4); r.P0 = qb * 256;
    return r;
}
__device__ __forceinline__ void fox_phase(Frame& F, char* lds) {
    constexpr int NQB = SEQ / 256, NX = NQB / 2, TOTAL = NB * NH * NX;
    const int lane = lane_id_v();
    int L = F.vcu; if (L >= TOTAL) return;
    int pass = 0;
    fox::Rsrc RS;
    RS.proj = __builtin_amdgcn_make_buffer_rsrc((void*)(F.ws + WS_PROJ), 0, 0x7ffffffc, 0x00020000);
    RS.att = __builtin_amdgcn_make_buffer_rsrc((void*)(F.ws + WS_ATT), 0, 0x7ffffffc, 0x00020000);
    RS.cum = __builtin_amdgcn_make_buffer_rsrc((void*)(F.ws + WS_CUMK), 0, 0x7ffffffc, 0x00020000);
    fox::BlockRef cur = fox_ref(L / NX, L % NX);
    fox::Seam S;
    fox::fox_prime(cur, RS, lds, F.lds, F.wave, lane, S);
    for (;;) {
        const bool more_pass = pass == 0, more_item = L + F.G < TOTAL, last = !more_pass && !more_item;
        int Ln = L, passn = pass + 1;
        if (!more_pass) { passn = 0; Ln = more_item ? L + F.G : L; }
        const int yn = Ln % NX;
        const fox::BlockRef nxt = last ? cur : fox_ref(Ln / NX, passn ? NQB - 1 - yn : yn);
        fox::fox_block(cur, nxt, RS, lds, F.lds, F.wave, lane, S);
        if (last) break;
        cur = nxt; pass = passn; L = Ln;
    }
}

constexpr int IDX_QT = 0;
__device__ __forceinline__ void indexer_phase(Frame& F) {
    const bf16_t* KI = (const bf16_t*)(F.ws + WS_KI);
    const float* SMALL = (const float*)(F.ws + WS_SMALL); float* SCORES = (float*)(F.ws + WS_SCORES);
    const __amdgpu_buffer_rsrc_t rp = __builtin_amdgcn_make_buffer_rsrc((void*)(F.ws + WS_PROJ), 0, 0x7ffffffc, 0x00020000);
    const int lane = lane_id_v(), wid = F.wave, r32 = lane & 31, hi = lane >> 5, wq = wid >> 1, wk = wid & 1;
    constexpr int UPB = 525, NU = NB * UPB;
    constexpr float WS = 0.17677669529663687f * 0.08838834764831845f;
    unsigned dsrc[4];
#pragma unroll
    for (int i = 0; i < 4; ++i) { const int row = 16 * wid + 4 * i + (lane >> 4); dsrc[i] = (unsigned)(row * PROJW + (((lane & 15) ^ (row & 7)) * 8)) * 2u; }
    const int qrow = wq * 32 + r32;
    unsigned kb[4];
#pragma unroll
    for (int dd = 0; dd < 4; ++dd) kb[dd] = (unsigned)(uintptr_t)F.lds + IDX_QT + (unsigned)(qrow * 256 + (((dd * 16 + hi * 8) * 2) ^ ((qrow & 7) << 4)));
#define IDX_DMA(hp, st) do { _Pragma("unroll") for (int e = 0; e < 2; ++e) { const unsigned so_ = qsoff + (unsigned)(2 * (hp) + e) * (IDIM * 2); _Pragma("unroll") for (int i = 0; i < 4; ++i) \
        __builtin_amdgcn_raw_ptr_buffer_load_lds(rp, (LAS void*)(F.lds + IDX_QT + (2 * (st) + e) * 32768 + wid * 4096 + i * 1024), 16, dsrc[i], so_, 0, 0); } } while (0)
#define IDX_PAIR(bo, wa, wb) do { bf16x8 qa[8], qb[8]; _Pragma("unroll") for (int d0 = 0; d0 < 8; ++d0) { qa[d0] = *(const LAS bf16x8*)(kb[d0 & 3] + (bo) + (d0 >> 2) * 128); qb[d0] = *(const LAS bf16x8*)(kb[d0 & 3] + (bo) + 32768u + (d0 >> 2) * 128); } \
        f32x16 a0 = {}, a1 = {}, b0 = {}, b1 = {}; \
        _Pragma("unroll") for (int kk = 0; kk < 8; ++kk) { a0 = __builtin_amdgcn_mfma_f32_32x32x16_bf16(ka[0][kk], qa[kk], a0, 0, 0, 0); a1 = __builtin_amdgcn_mfma_f32_32x32x16_bf16(ka[1][kk], qa[kk], a1, 0, 0, 0); } \
        _Pragma("unroll") for (int kk = 0; kk < 8; ++kk) { b0 = __builtin_amdgcn_mfma_f32_32x32x16_bf16(ka[0][kk], qb[kk], b0, 0, 0, 0); b1 = __builtin_amdgcn_mfma_f32_32x32x16_bf16(ka[1][kk], qb[kk], b1, 0, 0, 0); } \
        _Pragma("unroll") for (int r_ = 0; r_ < 16; ++r_) { sc0[r_] = fmaf((wa), fmaxf(a0[r_], 0.f), sc0[r_]); sc1[r_] = fmaf((wa), fmaxf(a1[r_], 0.f), sc1[r_]); } \
        _Pragma("unroll") for (int r_ = 0; r_ < 16; ++r_) { sc0[r_] = fmaf((wb), fmaxf(b0[r_], 0.f), sc0[r_]); sc1[r_] = fmaf((wb), fmaxf(b1[r_], 0.f), sc1[r_]); } } while (0)
    for (int u = F.vcu; u < NU; u += F.G) {
        const int b = u / UPB; int r = u % UPB, qt = 2; while (r >= qt + 1) { r -= qt + 1; ++qt; } const int kt = r;
        const int qbase = b * SEQ + qt * 128, q0 = qbase + wq * 32, key0 = b * SEQ + kt * 128 + wk * 64;
        const unsigned qsoff = (unsigned)(((size_t)qbase * PROJW + PC_QI) * 2);
        IDX_DMA(0, 0); IDX_DMA(1, 1);
        const float* wp = SMALL + (size_t)(q0 + r32) * 256 + SM_WI;
        f32x2 wn = *(const f32x2*)wp;
        bf16x8 ka[2][8];
#pragma unroll
        for (int mb = 0; mb < 2; ++mb)
#pragma unroll
            for (int kk = 0; kk < 8; ++kk) ka[mb][kk] = *(const bf16x8*)(KI + (size_t)(key0 + 32 * mb + r32) * IDIM + 16 * kk + 8 * hi);
        f32x16 sc0 = {}, sc1 = {};
        asm volatile("s_waitcnt vmcnt(0)" ::: "memory");
        __syncthreads();
#pragma unroll 1
        for (int hp = 0; hp < NIH / 2; ++hp) {
            const unsigned bo = (unsigned)(hp & 1) * 65536u;
            const f32x2 wc = wn * WS;
            if (hp + 1 < NIH / 2) wn = *(const f32x2*)(wp + 2 * hp + 2);
            IDX_PAIR(bo, wc.x, wc.y);
            asm volatile("s_waitcnt vmcnt(0)" ::: "memory");
            __syncthreads();
            if (hp + 2 < NIH / 2) IDX_DMA(hp + 2, hp & 1);
        }
        float* op = SCORES + (size_t)(q0 + r32) * SEQ + kt * 128 + wk * 64 + 4 * hi;
#pragma unroll
        for (int g = 0; g < 4; ++g) {
            *(f32x4*)(op + 8 * g) = (f32x4){sc0[4 * g], sc0[4 * g + 1], sc0[4 * g + 2], sc0[4 * g + 3]};
            *(f32x4*)(op + 32 + 8 * g) = (f32x4){sc1[4 * g], sc1[4 * g + 1], sc1[4 * g + 2], sc1[4 * g + 3]};
        }
    }
#undef IDX_DMA
#undef IDX_PAIR
}

template <int NR>
__device__ __forceinline__ void topk_row(const float* srow, int nreg, int* out, int lane) {
    unsigned key[NR];
#pragma unroll
    for (int j = 0; j < NR; ++j) {
        unsigned k = 0u;
        if (j < nreg) { const unsigned u = __float_as_uint(srow[j * 64 + lane]); k = (u & 0x80000000u) ? ~u : (u | 0x80000000u); }
        key[j] = k;
    }
    unsigned T = 0u;
    for (int bit = 31; bit >= 0; --bit) {
        const unsigned cand = T | (1u << bit); int c = 0;
#pragma unroll
        for (int j = 0; j < NR; ++j) c += (key[j] >= cand) ? 1 : 0;
#pragma unroll
        for (int o = 1; o < 64; o <<= 1) c += __shfl_xor(c, o);
        if (c >= TOPK) T = cand;
    }
    int cgt = 0;
#pragma unroll
    for (int j = 0; j < NR; ++j) cgt += (key[j] > T) ? 1 : 0;
#pragma unroll
    for (int o = 1; o < 64; o <<= 1) cgt += __shfl_xor(cgt, o);
    int bg = 0, be = cgt;
    unsigned T2 = T; asm volatile("" : "+v"(T2));
#pragma unroll
    for (int j = 0; j < NR; ++j) {
        const bool gt = key[j] > T2, eq = key[j] == T2;
        const unsigned long long mg = __ballot(gt), me = __ballot(eq);
        const int pg = bg + (int)__builtin_amdgcn_mbcnt_hi((unsigned)(mg >> 32), __builtin_amdgcn_mbcnt_lo((unsigned)mg, 0u));
        const int pe = be + (int)__builtin_amdgcn_mbcnt_hi((unsigned)(me >> 32), __builtin_amdgcn_mbcnt_lo((unsigned)me, 0u));
        if (gt) out[pg] = j * 64 + lane;
        if (eq && pe < TOPK) out[pe] = j * 64 + lane;
        bg += __popcll(mg); be += __popcll(me);
        __builtin_amdgcn_sched_barrier(0);
    }
}
__device__ __forceinline__ void topk_phase(Frame& F) {
    const float* SCORES = (const float*)(F.ws + WS_SCORES); int* IDX = (int*)(F.ws + WS_IDX);
    const int gw = F.vcu * NWAVES + F.wave, NGW = F.G * NWAVES, lane = lane_id_v();
    for (int row = gw; row < M; row += NGW) {
        const int t = row % SEQ, nreg = (t >> 6) + 1;
        int* out = IDX + (size_t)row * TOPK;
        if (nreg <= 4) { *(i32x4*)(out + lane * 4) = (i32x4){lane * 4, lane * 4 + 1, lane * 4 + 2, lane * 4 + 3}; continue; }
        const float* srow = SCORES + (size_t)row * SEQ;
        if (nreg <= 16) topk_row<16>(srow, nreg, out, lane);
        else if (nreg <= 32) topk_row<32>(srow, nreg, out, lane);
        else topk_row<64>(srow, nreg, out, lane);
    }
}

constexpr int DSA_TILE = 32 * 544, DSA_TAB = NWAVES * DSA_TILE;
__device__ __forceinline__ void dsa_phase(Frame& F, const float* rel_bias) {
    const bf16_t* CKV = (const bf16_t*)(F.ws + WS_CKV); bf16_t* QLAT = (bf16_t*)(F.ws + WS_QLAT); const int* IDX = (const int*)(F.ws + WS_IDX);
    LAS float* relb = (LAS float*)(F.lds + DSA_TAB); LAS int* lut = (LAS int*)(F.lds + DSA_TAB + 2048);
    const int lane = lane_id_v(), tid = F.wave * 64 + lane;
    for (int i = tid; i < 512; i += NWAVES * 64) relb[i] = rel_bias[i];
    if (tid < 128) { const int n = tid; lut[n] = n < 8 ? n : n < 12 ? 8 : n < 16 ? 9 : n < 23 ? 10 : n < 32 ? 11 : n < 46 ? 12 : n < 64 ? 13 : n < 91 ? 14 : 15; }
    __syncthreads();
    const int head = lane & 15, g = lane >> 4;
    const bool xdeal = (F.G == 256);
    const int xw = (F.vcu & 31) * NWAVES + F.wave, xbase = (F.vcu >> 5) * 2048;
    const int gw = xdeal ? xbase + xw : F.vcu * NWAVES + F.wave, NGW = xdeal ? 256 : F.G * NWAVES, rend = xdeal ? xbase + 2048 : M;
    LAS unsigned char* tile = F.lds + F.wave * DSA_TILE;
    const unsigned trbase = (unsigned)(uintptr_t)tile + (unsigned)((4 * g + ((lane & 15) >> 2)) * 544 + (lane & 3) * 8);
    const unsigned stw = (unsigned)(uintptr_t)tile + (unsigned)((lane >> 5) * 544 + (lane & 31) * 16);
    for (int row = gw; row < rend; row += NGW) {
        const int b = row / SEQ, t = row % SEQ; const int L = ((t >> 6) + 1) * 64, nsel = L < TOPK ? L : TOPK, ng = nsel >> 4;
        const int* irow = IDX + (size_t)row * TOPK;
        const __amdgpu_buffer_rsrc_t rc = __builtin_amdgcn_make_buffer_rsrc((void*)(CKV + (size_t)b * SEQ * DLAT), 0, SEQ * DLAT * 2, 0x00020000);
        const __amdgpu_buffer_rsrc_t rq = __builtin_amdgcn_make_buffer_rsrc((void*)(QLAT + (size_t)row * NH * DLAT), 0, NH * DLAT * 2, 0x00020000);
        f32x4 lg[16];
#pragma unroll
        for (int grp = 0; grp < 16; ++grp) lg[grp] = (f32x4){0.f, 0.f, 0.f, 0.f};
        const unsigned rdbase = (unsigned)(uintptr_t)tile + (unsigned)((lane & 15) * 544 + g * 16);
        const unsigned qo = (unsigned)(head * DLAT + 8 * g) * 2u;
#define DSA_G(kb, ho_) do { const int ridx_ = (32 * (kb) < nsel) ? irow[32 * (kb) + (lane & 31)] : 0; _Pragma("unroll") for (int i = 0; i < 16; ++i) { const int s_ = __shfl(ridx_, 2 * i + (lane >> 5)); v[i] = fox::bload8(rc, (unsigned)(s_ * DLAT) * 2u + (ho_), 0); } } while (0)
#pragma unroll 1
        for (int half = 0; half < 2; ++half) {
            bf16x8 qf[8], v[16];
#pragma unroll
            for (int kk = 0; kk < 8; ++kk) qf[kk] = fox::bload8(rq, qo + (unsigned)(half * 512 + kk * 64), 0);
            const unsigned ho = (unsigned)(half * 256 + (lane & 31) * 8) * 2u;
            DSA_G(0, ho);
#pragma unroll
            for (int kb = 0; kb < 8; ++kb) {
#pragma unroll
                for (int i = 0; i < 16; ++i) *(LAS bf16x8*)(stw + i * 1088) = v[i];
                if (kb + 1 < 8) DSA_G(kb + 1, ho);
#pragma unroll
                for (int kk = 0; kk < 8; ++kk) {
                    const bf16x8 a0 = *(const LAS bf16x8*)(rdbase + kk * 64), a1 = *(const LAS bf16x8*)(rdbase + 16 * 544 + kk * 64);
                    lg[2 * kb] = __builtin_amdgcn_mfma_f32_16x16x32_bf16(a0, qf[kk], lg[2 * kb], 0, 0, 0);
                    lg[2 * kb + 1] = __builtin_amdgcn_mfma_f32_16x16x32_bf16(a1, qf[kk], lg[2 * kb + 1], 0, 0, 0);
                }
            }
        }
#pragma unroll
        for (int grp = 0; grp < 16; ++grp) {
            const bool live = grp < ng;
            i32x4 sk = *(const i32x4*)(irow + grp * 16 + 4 * g);
#pragma unroll
            for (int i = 0; i < 4; ++i) { const int rel = live ? sk[i] - t : 0, n = rel < 0 ? -rel : rel; const int bk = lut[n < 127 ? n : 127] + (rel > 0 ? 16 : 0);
                const float v_ = lg[grp][i] * 0.08838834764831845f + relb[bk * 16 + head]; lg[grp][i] = live ? v_ : -1e30f; }
        }
        float mx = -1e30f;
#pragma unroll
        for (int grp = 0; grp < 16; ++grp) mx = fmaxf(fmaxf(mx, fmaxf(lg[grp][0], lg[grp][1])), fmaxf(lg[grp][2], lg[grp][3]));
        mx = fmaxf(mx, __shfl_xor(mx, 16)); mx = fmaxf(mx, __shfl_xor(mx, 32));
        float sum = 0.f;
#pragma unroll
        for (int grp = 0; grp < 16; ++grp)
#pragma unroll
            for (int i = 0; i < 4; ++i) { const float e = __builtin_amdgcn_exp2f((lg[grp][i] - mx) * 1.4426950408889634f); lg[grp][i] = e; sum += e; }
        sum += __shfl_xor(sum, 16); sum += __shfl_xor(sum, 32);
        const float inv = 1.f / sum;
        bf16x8 pb[8];
#pragma unroll
        for (int kb = 0; kb < 8; ++kb) { u32x4 w; w.x = cvt_pk_bf16(lg[2 * kb][0] * inv, lg[2 * kb][1] * inv); w.y = cvt_pk_bf16(lg[2 * kb][2] * inv, lg[2 * kb][3] * inv);
            w.z = cvt_pk_bf16(lg[2 * kb + 1][0] * inv, lg[2 * kb + 1][1] * inv); w.w = cvt_pk_bf16(lg[2 * kb + 1][2] * inv, lg[2 * kb + 1][3] * inv); pb[kb] = *reinterpret_cast<bf16x8*>(&w); }
#pragma unroll 1
        for (int half = 0; half < 2; ++half) {
            f32x4 oacc[16];
#pragma unroll
            for (int mb = 0; mb < 16; ++mb) oacc[mb] = (f32x4){0.f, 0.f, 0.f, 0.f};
            bf16x8 v[16];
            const unsigned ho = (unsigned)(half * 256 + (lane & 31) * 8) * 2u;
            DSA_G(0, ho);
#pragma unroll
            for (int kb = 0; kb < 8; ++kb) {
                {
#pragma unroll
                    for (int i = 0; i < 16; ++i) *(LAS bf16x8*)(stw + i * 1088) = v[i];
                    if (kb + 1 < 8) DSA_G(kb + 1, ho);
                    if (2 * kb < ng)
#pragma unroll
                    for (int mb = 0; mb < 16; ++mb) {
                        const s16x4 lo = __builtin_bit_cast(s16x4, __builtin_amdgcn_ds_read_tr16_b64_v4i16((LAS s16x4*)(trbase + mb * 32)));
                        const s16x4 hi4 = __builtin_bit_cast(s16x4, __builtin_amdgcn_ds_read_tr16_b64_v4i16((LAS s16x4*)(trbase + 16 * 544 + mb * 32)));
                        oacc[mb] = __builtin_amdgcn_mfma_f32_16x16x32_bf16((bf16x8){lo[0], lo[1], lo[2], lo[3], hi4[0], hi4[1], hi4[2], hi4[3]}, pb[kb], oacc[mb], 0, 0, 0);
                    }
                }
            }
#undef DSA_G
            bf16_t* op = (bf16_t*)(F.ws + WS_OLAT) + ((size_t)row * NH + head) * DLAT + half * 256 + 4 * g;
#pragma unroll
            for (int mb = 0; mb < 16; ++mb) { u32x2 w; w.x = cvt_pk_bf16(oacc[mb][0], oacc[mb][1]); w.y = cvt_pk_bf16(oacc[mb][2], oacc[mb][3]); *(u32x2*)(op + 16 * mb) = w; }
        }
    }
}

constexpr int NPHASE = 16;
struct Args { const float* in[22]; float* out; unsigned char* ws; int ph_lo, ph_hi; };
template <int OFF> __device__ __forceinline__ const float* karg_ptr() { unsigned long long v; asm volatile("s_load_dwordx2 %0, %1, %2\n\ts_waitcnt lgkmcnt(0)" : "=s"(v) : "s"(__builtin_amdgcn_kernarg_segment_ptr()), "n"(OFF) : "memory");
    return (const float*)(GAS const float*)v; }
template <int OFF> __device__ __forceinline__ int karg_int() { int v; asm volatile("s_load_dword %0, %1, %2\n\ts_waitcnt lgkmcnt(0)" : "=s"(v) : "s"(__builtin_amdgcn_kernarg_segment_ptr()), "n"(OFF) : "memory"); return v; }
#define ARGIN(k) karg_ptr<8 * (k)>()
__global__ void __launch_bounds__(NWAVES * 64, 2) mk_fwd(Args args) {
    extern __shared__ __attribute__((aligned(16))) unsigned char lds_raw[];
    Frame F;
    F.lds = (LAS unsigned char*)lds_raw;
    F.wave = __builtin_amdgcn_readfirstlane((int)threadIdx.x >> 6);
    F.G = gridDim.x; { const int bx = blockIdx.x; F.vcu = (F.G % 8 == 0) ? (bx % 8) * (F.G / 8) + bx / 8 : bx; }
    unsigned char* ws = (unsigned char*)karg_ptr<184>(); F.ws = ws;
    volatile LAS unsigned* MISC = (volatile LAS unsigned*)(F.lds + MISC_OFF);
    for (int u = (int)threadIdx.x; u < (LDS_BYTES - LDSCTL_OFF) / 4; u += NWAVES * 64) ((LAS unsigned*)(F.lds + LDSCTL_OFF))[u] = 0u;
    __syncthreads();
#if MK_SINGLE
    XcdBarrier bar = xcd_barrier_post((unsigned*)(ws + WS_CTL) + CW_BAR, MISC + 8, threadIdx.x == 0);
#define GRID_BAR() xcd_barrier(bar, F.wave == 0 && lane_id_v() == 0)
#else
    (void)MISC;
#define GRID_BAR() do {} while (0)
#endif
    const int lo = karg_int<192>(), hi = karg_int<196>();
#define IN(k) (lo <= (k) && (k) < hi)
#define BOTH(k) (IN(k) && IN((k) + 1))

    const float* x = ARGIN(0);
    bf16_t* XB = (bf16_t*)(ws + WS_XB); bf16_t* HID = (bf16_t*)(ws + WS_HID); bf16_t* H1B = (bf16_t*)(ws + WS_H1B); bf16_t* ATT = (bf16_t*)(ws + WS_ATT);
    bf16_t* PRE = (bf16_t*)(ws + WS_PRE);
    bf16_t* W1 = (bf16_t*)(ws + WS_W1); bf16_t* WD = (bf16_t*)(ws + WS_WD); bf16_t* WOUT = (bf16_t*)(ws + WS_WOUT);

    if (IN(0)) {
        convert_ffn(F, ARGIN(1), ARGIN(2), ARGIN(3));
        convert_misc(F, ARGIN(6), ARGIN(14), ARGIN(11), ARGIN(12), x);
        if (BOTH(0)) GRID_BAR();
    }
    if (IN(1)) {
        pg8::Gemm g{XB, W1, DM, DM, DM}; pg8::StaticOrder S; S.init(M, 2 * DFF, F.G, (int)blockIdx.x);
        pg8::EpiSwiglu E{HID, DFF};
        pg8::gemm_phase<pg8::EpiSwiglu, pg8::StaticOrder, true>(F.lds, F.wave, g, S, E);
        if (BOTH(1)) GRID_BAR();
    }
    if (IN(2)) {
        pg8::Gemm g{HID, WD, DFF, DFF, DFF}; pg8::StaticOrder S; S.init(M, DM, F.G, (int)blockIdx.x, 2);
        pg8::EpiResBf16<false> E{PRE, DM, x, DM, ALPHA, 0.5f};
        pg8::gemm_phase<pg8::EpiResBf16<false>, pg8::StaticOrder, true>(F.lds, F.wave, g, S, E);
        if (BOTH(2)) GRID_BAR();
    }
    if (IN(3)) { ln_phase<false>(F, PRE, ARGIN(4), ARGIN(5), H1B); if (BOTH(3)) GRID_BAR(); }
    bf16_t* PROJ = (bf16_t*)(ws + WS_PROJ); bf16_t* QLAT = (bf16_t*)(ws + WS_QLAT);
    if (IN(4)) {
        pg8::Gemm g{H1B, (const bf16_t*)(ws + WS_WIN), DM, DM, DM}; pg8::StaticOrder S; S.init(M, DINP, F.G, (int)blockIdx.x);
        pg8::EpiProj E{PROJ, (float*)(ws + WS_CKVRAW), (float*)(ws + WS_SMALL)};
        pg8::gemm_phase<pg8::EpiProj, pg8::StaticOrder, true>(F.lds, F.wave, g, S, E);
        if (BOTH(4)) GRID_BAR();
    }
    if (IN(5)) {
        p5_norms(F, ARGIN(8), ARGIN(9), ARGIN(10), ARGIN(7));
        __syncthreads();
        pg8::Gemm g{PROJ + PC_QA, (const bf16_t*)(ws + WS_WUK), PROJW, 256, 256}; pg8::QlatOrder S; S.init(M, NH * DLAT, F.G, (int)blockIdx.x);
        pg8::EpiBf16<false> E{QLAT, NH * DLAT};
        pg8::gemm_phase<pg8::EpiBf16<false>, pg8::QlatOrder, true>(F.lds, F.wave, g, S, E);
        if (BOTH(5)) GRID_BAR();
    }
    if (IN(6)) { __syncthreads(); indexer_phase(F); if (BOTH(6)) GRID_BAR(); }
    if (IN(7)) { topk_phase(F); if (BOTH(7)) GRID_BAR(); }
    if (IN(8)) { __syncthreads(); dsa_phase(F, ARGIN(13)); if (BOTH(8)) GRID_BAR(); }
    if (IN(9)) {
        pg8::Gemm g{(const bf16_t*)(ws + WS_OLAT), (const bf16_t*)(ws + WS_WUV), NH * DLAT, DLAT, DLAT}; pg8::OaOrder S; S.init(M, NH * 256, F.G, (int)blockIdx.x);
        pg8::EpiBf16<true> E{ATT, DM};
        pg8::gemm_phase<pg8::EpiBf16<true>, pg8::OaOrder, true>(F.lds, F.wave, g, S, E);
    }
    if (IN(10)) { __syncthreads(); fox_phase(F, (char*)lds_raw); if (BOTH(10)) GRID_BAR(); }
    if (IN(11)) {
        convert_ffn(F, ARGIN(17), ARGIN(18), ARGIN(19)); __syncthreads();
        pg8::Gemm g{ATT, WOUT, DM, DM, DM}; pg8::StaticOrder S; S.init(M, DM, F.G, (int)blockIdx.x);
        pg8::EpiResBf16<true> E{PRE, DM, H1B, DM, ALPHA, 1.0f};
        pg8::gemm_phase<pg8::EpiResBf16<true>, pg8::StaticOrder, true>(F.lds, F.wave, g, S, E);
        if (BOTH(11)) GRID_BAR();
    }
    if (IN(12)) { ln_phase<false>(F, PRE, ARGIN(15), ARGIN(16), H1B); if (BOTH(12)) GRID_BAR(); }
    if (IN(13)) {
        pg8::Gemm g{H1B, W1, DM, DM, DM}; pg8::StaticOrder S; S.init(M, 2 * DFF, F.G, (int)blockIdx.x);
        pg8::EpiSwiglu E{HID, DFF};
        pg8::gemm_phase<pg8::EpiSwiglu, pg8::StaticOrder, true>(F.lds, F.wave, g, S, E);
        if (BOTH(13)) GRID_BAR();
    }
    if (IN(14)) {
        pg8::Gemm g{HID, WD, DFF, DFF, DFF}; pg8::StaticOrder S; S.init(M, DM, F.G, (int)blockIdx.x, 2);
        pg8::EpiResBf16<true> E{PRE, DM, H1B, DM, ALPHA, 0.5f};
        pg8::gemm_phase<pg8::EpiResBf16<true>, pg8::StaticOrder, true>(F.lds, F.wave, g, S, E);
        if (BOTH(14)) GRID_BAR();
    }
    if (IN(15)) { ln_phase<true>(F, PRE, ARGIN(20), ARGIN(21), (float*)karg_ptr<176>()); }
#undef IN
#undef BOTH
}

extern "C" void kernel_launch(void* const* d_in, const int* in_sizes, int n_in, void* d_out, int out_size, void* d_ws, size_t ws_size, hipStream_t stream) {
    static int grid = 0;
    if (grid == 0) {
        if (n_in != 22 || in_sizes[0] != M * DM || out_size != M * DM || ws_size < WS_END) {
            fprintf(stderr, "kernel_launch: unexpected shapes: n_in %d in0 %d out %d ws %zu (need %zu)\n", n_in, n_in > 0 ? in_sizes[0] : -1, out_size, ws_size, (size_t)WS_END); grid = -1; return; }
        int dev = 0, cus = 0;
        if (hipGetDevice(&dev) != hipSuccess || hipDeviceGetAttribute(&cus, hipDeviceAttributeMultiprocessorCount, dev) != hipSuccess) { grid = -1; return; }
        if (hipFuncSetAttribute((const void*)mk_fwd, hipFuncAttributeMaxDynamicSharedMemorySize, LDS_BYTES) != hipSuccess) { fprintf(stderr, "kernel_launch: hipFuncSetAttribute failed\n"); grid = -1; return; }
        int per_cu = 0;
        if (hipOccupancyMaxActiveBlocksPerMultiprocessor(&per_cu, (const void*)mk_fwd, NWAVES * 64, LDS_BYTES) != hipSuccess || per_cu < 1) { fprintf(stderr, "kernel_launch: occupancy query says %d\n", per_cu); }
        (void)hipGetLastError();
        grid = cus;
    }
    if (grid < 0) return;
    (void)hipMemsetAsync((char*)d_ws + WS_CTL, 0, CTL_ZERO_BYTES, stream);
    Args a{};
    for (int i = 0; i < 22; ++i) a.in[i] = (const float*)d_in[i];
    a.out = (float*)d_out; a.ws = (unsigned char*)d_ws;
#if MK_SINGLE
    a.ph_lo = 0; a.ph_hi = NPHASE;
    hipLaunchKernelGGL(mk_fwd, dim3(grid), dim3(NWAVES * 64), LDS_BYTES, stream, a);
#else
    for (int p = 0; p < NPHASE; ++p) {
        a.ph_lo = p; a.ph_hi = p + 1;
        hipLaunchKernelGGL(mk_fwd, dim3(grid), dim3(NWAVES * 64), LDS_BYTES, stream, a);
    }
#endif
}
```
